# Optimizing an MI355X kernel written in HIP

```python
import math
import jax, jax.numpy as jnp
from jax import lax
import numpy as np

D_MODEL = 1024
BATCH = 8
SEQ = 2048
DEPTH = 4

CTX_LEN = 256
GRID_W = 64
DIFF_HEADS = 4
DIFF_HD = 64
DIFF_VD = 2 * DIFF_HD
MLA_HEADS = 8
MLA_NOPE = 64
MLA_ROPE = 32
MLA_VD = 64
MLA_Q_RANK = 384
MLA_KV_RANK = 256
FOURIER_GROUPS = 4
FOURIER_GROUP_DIM = 128
N_BRANCHES = 3
D_FF = 2816
Q_BLOCK = 128
ROPE_BASE = 10000.0
RMS_EPS = 1e-6
N_MOD = 9

DIFF_Q_W = DIFF_HEADS * 2 * DIFF_HD
DIFF_V_W = DIFF_HEADS * DIFF_VD
FOURIER_W = FOURIER_GROUPS * FOURIER_GROUP_DIM
MLA_OUT_W = MLA_HEADS * MLA_VD
IN_SIZES = (DIFF_Q_W, DIFF_Q_W, DIFF_V_W, MLA_Q_RANK, MLA_KV_RANK, MLA_ROPE, FOURIER_W, N_BRANCHES * D_MODEL)
IN_WIDTH = sum(IN_SIZES)

kernel_name = 'hybrid_diff_mla_fourier_macaron_dit'


def rms_norm(x, g):
    x32 = x.astype(jnp.float32)
    y = x32 * lax.rsqrt(jnp.mean(x32 * x32, axis=-1, keepdims=True) + RMS_EPS)
    return (y * g.astype(jnp.float32)).astype(x.dtype)


def modulate(x, shift, scale):
    return x * (1 + scale) + shift


def swiglu(x, w_in, w_out):
    g, u = jnp.split(x @ w_in, 2, axis=-1)
    return (jax.nn.silu(g) * u) @ w_out


def axial_rope_tables(row, col, dim):
    nf = dim // 4
    freqs = jnp.power(ROPE_BASE, -jnp.arange(nf, dtype=jnp.float32) / nf)
    ar = row.astype(jnp.float32)[:, None] * freqs[None, :]
    ac = col.astype(jnp.float32)[:, None] * freqs[None, :]
    ang = jnp.concatenate([ar, ar, ac, ac], axis=-1)
    return jnp.cos(ang), jnp.sin(ang)


def axial_rope(x, cos, sin):
    x1, x2, x3, x4 = jnp.split(x, 4, axis=-1)
    rot = jnp.concatenate([-x2, x1, -x4, x3], axis=-1)
    return (x * cos + rot * sin).astype(x.dtype)


def sweep_query_blocks(fn, qs):
    b, h, n, _ = qs[0].shape
    nb = n // Q_BLOCK
    blocks = tuple(q.reshape(b, h, nb, Q_BLOCK, q.shape[-1]).transpose(2, 0, 1, 3, 4) for q in qs)
    out = lax.map(lambda qb: fn(*qb), blocks)
    return out.transpose(1, 2, 0, 3, 4).reshape(b, h, n, out.shape[-1])


def diff_attend(q1, q2, k1, k2, v, lam):
    scale = DIFF_HD ** -0.5
    p1 = jax.nn.softmax(jnp.einsum('bhqd,bhkd->bhqk', q1, k1).astype(jnp.float32) * scale, axis=-1)
    p2 = jax.nn.softmax(jnp.einsum('bhqd,bhkd->bhqk', q2, k2).astype(jnp.float32) * scale, axis=-1)
    w = p1 - lam.astype(jnp.float32) * p2
    return jnp.einsum('bhqk,bhkv->bhqv', w.astype(v.dtype), v)


def mla_attend(qn, qr, kn, kr, v):
    scale = (MLA_NOPE + MLA_ROPE) ** -0.5
    s = jnp.einsum('bhqd,bhkd->bhqk', qn, kn) + jnp.einsum('bhqr,bkr->bhqk', qr, kr)
    p = jax.nn.softmax(s.astype(jnp.float32) * scale, axis=-1)
    return jnp.einsum('bhqk,bhkv->bhqv', p.astype(v.dtype), v)


def split_heads(t, heads, dim):
    b, n, _ = t.shape
    return t.reshape(b, n, heads, dim).transpose(0, 2, 1, 3)


def merge_heads(t):
    b, h, n, d = t.shape
    return t.transpose(0, 2, 1, 3).reshape(b, n, h * d)


def split_proj(p):
    offsets = []
    acc = 0
    for s in IN_SIZES[:-1]:
        acc += s
        offsets.append(acc)
    return jnp.split(p, offsets, axis=-1)


def diff_qkv(pq, pk, pv):
    b, n, _ = pq.shape
    q = pq.reshape(b, n, DIFF_HEADS, 2, DIFF_HD).transpose(3, 0, 2, 1, 4)
    k = pk.reshape(b, n, DIFF_HEADS, 2, DIFF_HD).transpose(3, 0, 2, 1, 4)
    v = split_heads(pv, DIFF_HEADS, DIFF_VD)
    return q[0], q[1], k[0], k[1], v


def diff_out(o, subln_g, lam_init):
    return merge_heads(rms_norm(o, subln_g) * (1.0 - lam_init))


def mla_qkv(pcq, pckv, q_norm_g, w_uq, kv_norm_g, w_ukv):
    q = split_heads(rms_norm(pcq, q_norm_g) @ w_uq, MLA_HEADS, MLA_NOPE + MLA_ROPE)
    kv = split_heads(rms_norm(pckv, kv_norm_g) @ w_ukv, MLA_HEADS, MLA_NOPE + MLA_VD)
    return q[..., :MLA_NOPE], q[..., MLA_NOPE:], kv[..., :MLA_NOPE], kv[..., MLA_NOPE:]


def fourier_mix(pf):
    b, n, _ = pf.shape
    f = pf.reshape(b, n, FOURIER_GROUPS, FOURIER_GROUP_DIM).astype(jnp.float32)
    y = jnp.fft.fft2(f, axes=(1, 3), norm='ortho').real
    return y.reshape(b, n, FOURIER_W).astype(pf.dtype)


def merge_branches(pg, yd, ym, yf, w_bd, w_bm, w_bf, w_o):
    g = jax.nn.sigmoid(pg.reshape(pg.shape[:-1] + (N_BRANCHES, D_MODEL)))
    merged = g[..., 0, :] * (yd @ w_bd) + g[..., 1, :] * (ym @ w_bm) + g[..., 2, :] * (yf @ w_bf)
    return merged @ w_o


def setup_inputs(seed: int = 0) -> dict:
    key = jax.random.key(seed)
    ks = jax.random.split(key, 24)

    def nrm(k, shape, s):
        return jax.random.normal(k, shape, jnp.float32) * s

    def gain(k, shape):
        return 1.0 + 0.02 * jax.random.normal(k, shape, jnp.float32)

    return {
        'x': nrm(ks[0], (BATCH, SEQ, D_MODEL), 1.0),
        'c': nrm(ks[1], (BATCH, D_MODEL), 1.0),
        'ctx': nrm(ks[2], (BATCH, CTX_LEN, D_MODEL), 1.0),
        'c_ctx': nrm(ks[3], (D_MODEL,), 1.0),
        'ada_w': nrm(ks[4], (DEPTH, D_MODEL, N_MOD * D_MODEL), 0.5 * D_MODEL ** -0.5),
        'ada_b': nrm(ks[5], (DEPTH, N_MOD * D_MODEL), 0.02),
        'norm_g': gain(ks[6], (DEPTH, 3, D_MODEL)),
        'ffn_w_in': nrm(ks[7], (DEPTH, 2, D_MODEL, 2 * D_FF), D_MODEL ** -0.5),
        'ffn_w_out': nrm(ks[8], (DEPTH, 2, D_FF, D_MODEL), D_FF ** -0.5),
        'w_in': nrm(ks[9], (DEPTH, D_MODEL, IN_WIDTH), D_MODEL ** -0.5),
        'diff_lambda': nrm(ks[10], (DEPTH, 4, DIFF_HD), 0.1),
        'diff_subln_g': gain(ks[11], (DEPTH, DIFF_VD)),
        'mla_q_norm_g': gain(ks[12], (DEPTH, MLA_Q_RANK)),
        'mla_w_uq': nrm(ks[13], (DEPTH, MLA_Q_RANK, MLA_HEADS * (MLA_NOPE + MLA_ROPE)), MLA_Q_RANK ** -0.5),
        'mla_kv_norm_g': gain(ks[14], (DEPTH, MLA_KV_RANK)),
        'mla_w_ukv': nrm(ks[15], (DEPTH, MLA_KV_RANK, MLA_HEADS * (MLA_NOPE + MLA_VD)), MLA_KV_RANK ** -0.5),
        'w_branch_diff': nrm(ks[16], (DEPTH, DIFF_V_W, D_MODEL), DIFF_V_W ** -0.5),
        'w_branch_mla': nrm(ks[17], (DEPTH, MLA_OUT_W, D_MODEL), MLA_OUT_W ** -0.5),
        'w_branch_fourier': nrm(ks[18], (DEPTH, FOURIER_W, D_MODEL), FOURIER_W ** -0.5),
        'w_out': nrm(ks[19], (DEPTH, D_MODEL, D_MODEL), D_MODEL ** -0.5),
        'final_norm_g': gain(ks[20], (D_MODEL,)),
    }


def reference(x, c, ctx, c_ctx, ada_w, ada_b, norm_g, ffn_w_in, ffn_w_out, w_in, diff_lambda,
              diff_subln_g, mla_q_norm_g, mla_w_uq, mla_kv_norm_g, mla_w_ukv, w_branch_diff,
              w_branch_mla, w_branch_fourier, w_out, final_norm_g):
    n_lat = x.shape[1]
    rows = n_lat // GRID_W
    t_row = jnp.repeat(jnp.arange(rows), GRID_W)
    t_col = jnp.tile(jnp.arange(GRID_W), rows)
    cos_d, sin_d = axial_rope_tables(t_row, t_col, DIFF_HD)
    cos_m, sin_m = axial_rope_tables(t_row, t_col, MLA_ROPE)

    for l in range(DEPTH):
        last = l == DEPTH - 1
        mx = jnp.split((jax.nn.silu(c) @ ada_w[l] + ada_b[l])[:, None, :], N_MOD, axis=-1)
        mc = jnp.split(jax.nn.silu(c_ctx) @ ada_w[l] + ada_b[l], N_MOD, axis=-1)

        x = x + 0.5 * mx[2] * swiglu(modulate(rms_norm(x, norm_g[l, 0]), mx[0], mx[1]),
                                     ffn_w_in[l, 0], ffn_w_out[l, 0])
        ctx = ctx + 0.5 * mc[2] * swiglu(modulate(rms_norm(ctx, norm_g[l, 0]), mc[0], mc[1]),
                                         ffn_w_in[l, 0], ffn_w_out[l, 0])

        px = split_proj(modulate(rms_norm(x, norm_g[l, 1]), mx[3], mx[4]) @ w_in[l])
        pc = split_proj(modulate(rms_norm(ctx, norm_g[l, 1]), mc[3], mc[4]) @ w_in[l])

        lam_init = 0.8 - 0.6 * math.exp(-0.3 * l)
        lam = (jnp.exp(jnp.sum(diff_lambda[l, 0] * diff_lambda[l, 1]))
               - jnp.exp(jnp.sum(diff_lambda[l, 2] * diff_lambda[l, 3])) + lam_init)
        q1x, q2x, k1x, k2x, vx = diff_qkv(px[0], px[1], px[2])
        q1x, q2x, k1x, k2x = (axial_rope(t, cos_d, sin_d) for t in (q1x, q2x, k1x, k2x))
        q1c, q2c, k1c, k2c, vc = diff_qkv(pc[0], pc[1], pc[2])
        k1 = jnp.concatenate([k1c, k1x], axis=2)
        k2 = jnp.concatenate([k2c, k2x], axis=2)
        vd = jnp.concatenate([vc, vx], axis=2)
        od_x = sweep_query_blocks(lambda a, b: diff_attend(a, b, k1, k2, vd, lam), (q1x, q2x))
        yd_x = diff_out(od_x, diff_subln_g[l], lam_init)

        qnx, qrx, knx, vmx = mla_qkv(px[3], px[4], mla_q_norm_g[l], mla_w_uq[l], mla_kv_norm_g[l], mla_w_ukv[l])
        qrx = axial_rope(qrx, cos_m, sin_m)
        krx = axial_rope(px[5], cos_m, sin_m)
        qnc, qrc, knc, vmc = mla_qkv(pc[3], pc[4], mla_q_norm_g[l], mla_w_uq[l], mla_kv_norm_g[l], mla_w_ukv[l])
        krc = pc[5]
        kn = jnp.concatenate([knc, knx], axis=2)
        kr = jnp.concatenate([krc, krx], axis=1)
        vm = jnp.concatenate([vmc, vmx], axis=2)
        om_x = sweep_query_blocks(lambda a, b: mla_attend(a, b, kn, kr, vm), (qnx, qrx))
        ym_x = merge_heads(om_x)

        yf_x = fourier_mix(px[6])

        x = x + mx[5] * merge_branches(px[7], yd_x, ym_x, yf_x, w_branch_diff[l], w_branch_mla[l],
                                       w_branch_fourier[l], w_out[l])
        x = x + 0.5 * mx[8] * swiglu(modulate(rms_norm(x, norm_g[l, 2]), mx[6], mx[7]),
                                     ffn_w_in[l, 1], ffn_w_out[l, 1])

        if not last:
            od_c = diff_attend(q1c, q2c, k1c, k2c, vc, lam)
            yd_c = diff_out(od_c, diff_subln_g[l], lam_init)
            ym_c = merge_heads(mla_attend(qnc, qrc, knc, krc, vmc))
            yf_c = fourier_mix(pc[6])
            ctx = ctx + mc[5] * merge_branches(pc[7], yd_c, ym_c, yf_c, w_branch_diff[l], w_branch_mla[l],
                                               w_branch_fourier[l], w_out[l])
            ctx = ctx + 0.5 * mc[8] * swiglu(modulate(rms_norm(ctx, norm_g[l, 2]), mc[6], mc[7]),
                                             ffn_w_in[l, 1], ffn_w_out[l, 1])

    return rms_norm(x, final_norm_g)
```

```cpp
#include <hip/hip_runtime.h>
#include <hip/hip_cooperative_groups.h>
#include <cstdio>
namespace cg = cooperative_groups;

#ifndef ONE_LAUNCH
#define ONE_LAUNCH 1
#endif

#define LAS __attribute__((address_space(3)))
#define DI __device__ __forceinline__
typedef unsigned short bf16_t;
typedef short bf16x8 __attribute__((ext_vector_type(8)));
typedef float f32x4 __attribute__((ext_vector_type(4)));
typedef float f32x16 __attribute__((ext_vector_type(16)));
typedef unsigned u32x4 __attribute__((ext_vector_type(4)));
typedef unsigned u32x2 __attribute__((ext_vector_type(2)));

constexpr int DM = 1024, NB = 8, SEQ = 2048, CTX = 256, TPB = SEQ + CTX  , T = NB * TPB  ;
constexpr int DEPTH = 4, DFF = 2816, INW = 5792, NMOD = 9;
constexpr int NT = 512;
constexpr int LDS_BYTES = 147456;
constexpr float RMS_EPS = 1e-6f;

constexpr size_t al256(size_t x) { return (x + 255) & ~(size_t)255; }
constexpr size_t OFF_H = 0;
constexpr size_t OFF_AN = OFF_H + (size_t)T * DM * 4;
constexpr size_t OFF_R1 = OFF_AN + (size_t)T * DM * 2;
constexpr size_t OFF_QD = OFF_R1 + (size_t)T * 3072 * 2;
constexpr size_t OFF_KD = OFF_QD + (size_t)T * 512 * 2;
constexpr size_t OFF_VTD = OFF_KD + (size_t)T * 512 * 2;
constexpr size_t OFF_FT = OFF_VTD + (size_t)T * 512 * 2;
constexpr size_t OFF_FTC = OFF_FT + (size_t)NB * 512 * 4096 * 2;
constexpr size_t OFF_QM = OFF_FTC + (size_t)NB * 512 * 512 * 2;
constexpr size_t OFF_KM = OFF_QM + (size_t)T * 768 * 2;
constexpr size_t OFF_VTM = OFF_KM + (size_t)T * 768 * 2;
constexpr size_t OFF_Y = OFF_VTM + (size_t)T * 512 * 2;
constexpr size_t OFF_PQ = OFF_Y;
constexpr size_t OFF_CKV = OFF_PQ + (size_t)T * 512 * 2;
constexpr size_t OFF_RSQ = OFF_Y + (size_t)T * 1536 * 2;
constexpr size_t OFF_RSKV = OFF_RSQ + (size_t)T * 4;
constexpr size_t OFF_MOD = OFF_RSKV + (size_t)T * 4;
constexpr size_t OFF_ROPED = OFF_MOD + (size_t)DEPTH * 9 * 9216 * 4;
constexpr size_t OFF_ROPEM = OFF_ROPED + (size_t)2048 * 32 * 8;
constexpr size_t OFF_LAM = OFF_ROPEM + (size_t)2048 * 16 * 8;
constexpr size_t OFF_DFTL = OFF_LAM + 256;
constexpr size_t OFF_DFTC = OFF_DFTL + (size_t)2048 * 4096 * 2;
constexpr size_t OFF_W = OFF_DFTC + (size_t)256 * 512 * 2;
constexpr size_t WE_W1 = 0;
constexpr size_t WE_W2 = WE_W1 + (size_t)2 * 5632 * 1024;
constexpr size_t WE_IN = WE_W2 + (size_t)2 * 1024 * 2816;
constexpr size_t WE_V = WE_IN + (size_t)4864 * 1024;
constexpr size_t WE_F = WE_V + (size_t)512 * 1024;
constexpr size_t WE_UQ = WE_F + (size_t)1024 * 1024;
constexpr size_t WE_UK = WE_UQ + (size_t)768 * 384;
constexpr size_t WE_UV = WE_UK + (size_t)512 * 256;
constexpr size_t WE_B = WE_UV + (size_t)512 * 256;
constexpr size_t WE_O = WE_B + (size_t)3 * 1024 * 512;
constexpr size_t WE_END = WE_O + (size_t)1024 * 1024;
constexpr size_t WS_NEED = OFF_W + (size_t)DEPTH * WE_END * 2;

struct Params {
    const float *x, *c, *ctx, *c_ctx, *ada_w, *ada_b, *norm_g, *ffn_w_in, *ffn_w_out, *w_in, *diff_lambda, *diff_subln_g, *mla_q_norm_g, *mla_w_uq,
        *mla_kv_norm_g, *mla_w_ukv, *w_bd, *w_bm, *w_bf, *w_out, *final_g;
    float* out; unsigned char* ws; int ph_lo, ph_hi;
};

DI unsigned pk2(float a, float b) {
    typedef float f2 __attribute__((ext_vector_type(2))); typedef __bf16 b2 __attribute__((ext_vector_type(2)));
    f2 v = {a, b}; b2 r = __builtin_convertvector(v, b2); return __builtin_bit_cast(unsigned, r);
}
DI float bflo(unsigned w) { return __uint_as_float(w << 16); }
DI float bfhi(unsigned w) { return __uint_as_float(w & 0xffff0000u); }
DI void store8(bf16_t* p, f32x4 a, f32x4 b) { u32x4 w = {pk2(a[0], a[1]), pk2(a[2], a[3]), pk2(b[0], b[1]), pk2(b[2], b[3])}; *(u32x4*)p = w; }
DI void load8(const bf16_t* p, f32x4& a, f32x4& b) { const u32x4 w = *(const u32x4*)p; a = (f32x4){bflo(w.x), bfhi(w.x), bflo(w.y), bfhi(w.y)}; b = (f32x4){bflo(w.z), bfhi(w.z), bflo(w.w), bfhi(w.w)}; }
DI float fast_exp2(float x) { return __builtin_amdgcn_exp2f(x); }
DI float sigmoidf_(float x) { return __builtin_amdgcn_rcpf(1.0f + fast_exp2(-1.44269504f * x)); }
DI float wave_sum(float v) { v += __shfl_xor(v, 32); v += __shfl_xor(v, 16); v += __shfl_xor(v, 8); v += __shfl_xor(v, 4); v += __shfl_xor(v, 2); v += __shfl_xor(v, 1); return v; }

DI void rope4(f32x4& v, const float* tab, float sg, int xm) {
    f32x4 q;
#pragma unroll
    for (int i = 0; i < 4; ++i) q[i] = __shfl_xor(v[i], xm);
    const f32x4 t0 = *(const f32x4*)tab, t1 = *(const f32x4*)(tab + 4);
    v[0] = v[0] * t0[0] + sg * q[0] * t0[1]; v[1] = v[1] * t0[2] + sg * q[1] * t0[3];
    v[2] = v[2] * t1[0] + sg * q[2] * t1[1]; v[3] = v[3] * t1[2] + sg * q[3] * t1[3];
}
DI void rope8(f32x4& v0, f32x4& v1, const float* tab, bool first, int xm) {
    const float sg = first ? -1.f : 1.f;
    rope4(v0, tab, sg, xm); asm volatile("" ::: "memory");
    rope4(v1, tab + 8, sg, xm); asm volatile("" ::: "memory");
}

namespace pg8 {
constexpr int BM = 256, BK = 64, HALF = 128, HTB = HALF * BK * 2, STAGE_BYTES = 8 * HTB;
DI int lds_byte(int r, int c) { const int st = (r >> 4) * 2 + (c >> 5), rr = r & 15, cc = c & 31, ob = rr * 64 + cc * 2; return st * 1024 + (ob ^ (((ob >> 9) & 1) << 5)); }
DI void stage_rc(int b, int& R, int& C) { const int st = b / 1024, sb = b % 1024, swz = sb ^ (((sb >> 9) & 1) << 5); R = (st >> 1) * 16 + swz / 64; C = (st & 1) * 32 + (swz % 64) / 2; }
DI int perm32(int rho) { const int n = rho >> 4, i = rho & 15; return 8 * (i >> 2) + 4 * n + (i & 3); }

struct Unit { const char* a; const char* b; int pm, pn, s, z; };

struct Sub { const char* A; const char* B; int nM, nN, mmod; size_t tsa, tsb, zb; };
struct Sched {
    Sub s0, s1, s2; int ns, G, c, rep; size_t za, zb;
    DI bool pick(const Sub& S, int sid, long& L, int z, Unit& u) const {
        const long cnt = (long)S.nM * S.nN;
        if (L >= cnt) { L -= cnt; return false; }
        const int w = (int)L, nig = 8 * S.nN, gid = w / nig, fm = gid * 8, gsz = (S.nM - fm) < 8 ? (S.nM - fm) : 8;
        u.pm = fm + ((w % nig) % gsz); u.pn = (w % nig) / gsz; u.s = sid; u.z = z;
        u.a = S.A + (size_t)(u.pm % S.mmod) * S.tsa + (size_t)z * za;
        u.b = S.B + (size_t)u.pn * S.tsb + (size_t)(u.pm / S.mmod) * S.zb + (size_t)z * zb;
        return true;
    }
    DI bool next(int i, Unit& u) const {
        const int j = i / rep, z = i - j * rep;
        long L = (long)j * G + c;
        if (pick(s0, 0, L, z, u)) return true;
        if (ns > 1 && pick(s1, 1, L, z, u)) return true;
        if (ns > 2 && pick(s2, 2, L, z, u)) return true;
        return false;
    }
};
DI Sub mksub(const void* A, const void* B, int nM, int nN, int lda, int ldb) { Sub s; s.A = (const char*)A; s.B = (const char*)B; s.nM = nM; s.nN = nN; s.mmod = 1 << 30; s.tsa = (size_t)256 * lda * 2; s.tsb = (size_t)256 * ldb * 2; s.zb = 0; return s; }

template <class Epi>
DI void gemm_phase(LAS unsigned char* lds, const int K, const int lda, const int ldb, const Sched& S, const Epi& E) {
    int tid = threadIdx.x; asm volatile("" : "+v"(tid));
    const int wid = __builtin_amdgcn_readfirstlane(tid >> 6), lane = tid & 63, wr = wid >> 2, wc = wid & 3, fr = lane & 15, fq = lane >> 4;
    const int nt = K / BK;
    unsigned voffA[2], voffB[2];
#pragma unroll
    for (int i = 0; i < 2; ++i) { int R, C; stage_rc(tid * 16 + i * 8192, R, C); const int Rb = Epi::PERM ? ((R & ~31) + perm32(R & 31)) : R;
        voffA[i] = (unsigned)(R * lda + C) * 2u; voffB[i] = (unsigned)(Rb * ldb + C) * 2u; }
    const size_t kstep = (size_t)(BK * 2);
    const size_t hsA = (size_t)HALF * lda * 2, hsB = (size_t)HALF * ldb * 2;
    const unsigned ldsw = (unsigned)wid * 1024u;
    const int aoff = lds_byte(wr * 64 + fr, fq * 8), boff = lds_byte(wc * 32 + fr, fq * 8);
#define PG8_SA(b, h) (((b) * 2 + (h)) * HTB)
#define PG8_SB(b, h) ((4 + (b) * 2 + (h)) * HTB)
#define PG8_STAGE(bufoff, gbase, voff) do { _Pragma("unroll") for (int _i = 0; _i < 2; ++_i) \
        __builtin_amdgcn_global_load_lds((const unsigned*)((const char*)(gbase) + (voff)[_i]), (LAS unsigned*)(lds + (bufoff) + ldsw + _i * 8192), 16, 0, 0); } while (0)
#define PG8_LDA(dst, b, h) do { _Pragma("unroll") for (int m = 0; m < 4; ++m) _Pragma("unroll") for (int k = 0; k < 2; ++k) dst[m][k] = *(const LAS bf16x8*)(lds + PG8_SA(b, h) + aoff + m * 2048 + k * 1024); } while (0)
#define PG8_LDB(dst, b, h) do { _Pragma("unroll") for (int n = 0; n < 2; ++n) _Pragma("unroll") for (int k = 0; k < 2; ++k) dst[n][k] = *(const LAS bf16x8*)(lds + PG8_SB(b, h) + boff + n * 2048 + k * 1024); } while (0)
#define PG8_MMA(ai, bj, At, Bt) do { __builtin_amdgcn_s_setprio(1); _Pragma("unroll") for (int m = 0; m < 4; ++m) _Pragma("unroll") for (int n = 0; n < 2; ++n) _Pragma("unroll") for (int k = 0; k < 2; ++k) \
        acc[ai][bj][m][n] = __builtin_amdgcn_mfma_f32_16x16x32_bf16(Bt[n][k], At[m][k], acc[ai][bj][m][n], 0, 0, 0); __builtin_amdgcn_s_setprio(0); } while (0)
#define PG8_WAIT_V(n) asm volatile("s_waitcnt vmcnt(" #n ")" ::: "memory")
#define PG8_WAIT_L(n) asm volatile("s_waitcnt lgkmcnt(" #n ")" ::: "memory")
#define PG8_BAR __builtin_amdgcn_s_barrier()
#define PG8_SCHED __builtin_amdgcn_sched_barrier(0)
    Unit cur, nxt; int ui = 0;
    if (!S.next(0, cur)) return;
    f32x4 acc[2][2][4][2];
#pragma unroll
    for (int a = 0; a < 2; ++a)
#pragma unroll
        for (int b = 0; b < 2; ++b)
#pragma unroll
            for (int m = 0; m < 4; ++m)
#pragma unroll
                for (int n = 0; n < 2; ++n) acc[a][b][m][n] = (f32x4){0.f, 0.f, 0.f, 0.f};
    bf16x8 At[4][2], B0[2][2], B1[2][2];
    const char* cA = cur.a; const char* cB = cur.b;
    PG8_STAGE(PG8_SB(0, 0), cB, voffB); PG8_STAGE(PG8_SA(0, 0), cA, voffA); PG8_STAGE(PG8_SB(0, 1), cB + hsB, voffB); PG8_STAGE(PG8_SA(0, 1), cA + hsA, voffA);
    if (wr == 1) PG8_BAR;
    PG8_WAIT_V(4); PG8_BAR;
    PG8_STAGE(PG8_SB(1, 0), cB + kstep, voffB); PG8_STAGE(PG8_SA(1, 0), cA + kstep, voffA); PG8_STAGE(PG8_SB(1, 1), cB + hsB + kstep, voffB);
    PG8_WAIT_V(6); PG8_BAR;
    for (;;) {
        const bool has_next = S.next(ui + 1, nxt);
        const char* nA = has_next ? nxt.a : cA; const char* nB = has_next ? nxt.b : cB;
        for (int t = 0; t < nt; t += 2) {
            const bool last = (t == nt - 2);
            const char* a1 = cA + (size_t)(t + 1) * kstep;
            const char* a2 = last ? nA : cA + (size_t)(t + 2) * kstep; const char* b2 = last ? nB : cB + (size_t)(t + 2) * kstep;
            const char* a3 = a2 + kstep; const char* b3 = b2 + kstep;
            PG8_LDB(B0, 0, 0); PG8_SCHED; PG8_LDA(At, 0, 0); PG8_STAGE(PG8_SA(1, 1), a1 + hsA, voffA);
            PG8_WAIT_L(8); PG8_BAR; PG8_WAIT_L(0); PG8_MMA(0, 0, At, B0); PG8_BAR; PG8_SCHED;
            PG8_LDB(B1, 0, 1); PG8_STAGE(PG8_SB(0, 0), b2, voffB);
            PG8_BAR; PG8_WAIT_L(0); PG8_MMA(0, 1, At, B1); PG8_BAR;
            PG8_LDA(At, 0, 1); PG8_STAGE(PG8_SA(0, 0), a2, voffA);
            PG8_BAR; PG8_WAIT_L(0); PG8_MMA(1, 0, At, B0); PG8_BAR; PG8_SCHED;
            PG8_STAGE(PG8_SB(0, 1), b2 + hsB, voffB);
            PG8_WAIT_V(6); PG8_BAR; PG8_MMA(1, 1, At, B1); PG8_BAR;
            PG8_LDB(B0, 1, 0); PG8_SCHED; PG8_LDA(At, 1, 0); PG8_STAGE(PG8_SA(0, 1), a2 + hsA, voffA);
            PG8_WAIT_L(8); PG8_BAR; PG8_WAIT_L(0); PG8_MMA(0, 0, At, B0); PG8_BAR; PG8_SCHED;
            PG8_LDB(B1, 1, 1); PG8_STAGE(PG8_SB(1, 0), b3, voffB);
            PG8_BAR; PG8_WAIT_L(0); PG8_MMA(0, 1, At, B1); PG8_BAR;
            PG8_LDA(At, 1, 1); PG8_STAGE(PG8_SA(1, 0), a3, voffA);
            PG8_BAR; PG8_WAIT_L(0); PG8_MMA(1, 0, At, B0); PG8_BAR; PG8_SCHED;
            PG8_STAGE(PG8_SB(1, 1), b3 + hsB, voffB);
            PG8_WAIT_V(6); PG8_BAR; PG8_MMA(1, 1, At, B1); PG8_BAR;
        }
        { int fr2 = fr, fq2 = fq; asm volatile("" : "+v"(fr2), "+v"(fq2));
          E(acc, cur, wr, wc, fr2, fq2); }
        if (!has_next) break;
#pragma unroll
        for (int a = 0; a < 2; ++a)
#pragma unroll
            for (int b = 0; b < 2; ++b)
#pragma unroll
                for (int m = 0; m < 4; ++m)
#pragma unroll
                    for (int n = 0; n < 2; ++n) acc[a][b][m][n] = (f32x4){0.f, 0.f, 0.f, 0.f};
        cur = nxt; cA = nA; cB = nB; ++ui;
    }
    PG8_WAIT_V(0);
    if (wr == 0) PG8_BAR;
    PG8_BAR;
#undef PG8_SA
#undef PG8_SB
#undef PG8_STAGE
#undef PG8_LDA
#undef PG8_LDB
#undef PG8_MMA
#undef PG8_WAIT_V
#undef PG8_WAIT_L
#undef PG8_BAR
#undef PG8_SCHED
}
}
using pg8::Unit;
typedef const f32x4 (&AccRef)[2][2][4][2];

struct EpiSwiglu {
    static constexpr bool PERM = true;
    bf16_t* ACT;
    DI void operator()(AccRef acc, const Unit& u, int wr, int wc, int fr, int fq) const {
        const int row0 = u.pm * 256 + wr * 64 + fr, col0 = u.pn * 128 + wc * 32 + 8 * fq;
#pragma unroll
        for (int ai = 0; ai < 2; ++ai)
#pragma unroll
            for (int m = 0; m < 4; ++m) {
                f32x4 o[2];
#pragma unroll
                for (int n = 0; n < 2; ++n)
#pragma unroll
                    for (int i = 0; i < 4; ++i) { const float g = acc[ai][0][m][n][i]; o[n][i] = g * sigmoidf_(g) * acc[ai][1][m][n][i]; }
                store8(ACT + (size_t)(row0 + ai * 128 + m * 16) * DFF + col0, o[0], o[1]);
            }
    }
};
struct EpiResid {
    static constexpr bool PERM = false;
    float* H; const float* modl; int gidx; float fac;
    DI void operator()(AccRef acc, const Unit& u, int wr, int wc, int fr, int fq) const {
        const int mrow = (u.pm % 9 == 0) ? 8 : u.pm / 9;
        const float* gate = modl + (size_t)mrow * 9216 + gidx * 1024;
        const int row0 = u.pm * 256 + wr * 64 + fr, col0 = u.pn * 256 + wc * 32 + 4 * fq;
        f32x4 gv[2][2];
#pragma unroll
        for (int bj = 0; bj < 2; ++bj)
#pragma unroll
            for (int n = 0; n < 2; ++n) gv[bj][n] = *(const f32x4*)(gate + col0 + bj * 128 + n * 16) * fac;
#pragma unroll
        for (int ai = 0; ai < 2; ++ai)
#pragma unroll
            for (int m = 0; m < 4; ++m) {
                float* rowp = H + (size_t)(row0 + ai * 128 + m * 16) * DM + col0;
#pragma unroll
                for (int bj = 0; bj < 2; ++bj)
#pragma unroll
                    for (int n = 0; n < 2; ++n) { f32x4* p = (f32x4*)(rowp + bj * 128 + n * 16); *p = *p + gv[bj][n] * acc[ai][bj][m][n]; }
            }
    }
};
struct EpiIn {
    static constexpr bool PERM = true;
    bf16_t *QD, *KD, *PQ, *CKV, *G, *KM, *VTD, *FT, *FTC; float *rsq, *rskv; const float *RD, *RM;
    DI void operator()(AccRef acc, const Unit& u, int wr, int wc, int fr, int fq) const {
        if (u.s == 0) {
            const int pn = u.pn, tt = u.pm % 9; const bool lat = tt != 0;
            const int rl0 = wr * 64 + fr;
            if (pn < 4) {
                bf16_t* dst = (pn < 2) ? QD : KD;
                const int colb = (pn & 1) * 256 + wc * 32 + 8 * fq, sel = wc & 1; const bool first = (fq >> 1) == 0;
#pragma unroll
                for (int ai = 0; ai < 2; ++ai)
#pragma unroll
                    for (int m = 0; m < 4; ++m) {
                        const int rl = rl0 + ai * 128 + m * 16; const size_t row = (size_t)u.pm * 256 + rl; const int pos = (tt - 1) * 256 + rl;
#pragma unroll
                        for (int bj = 0; bj < 2; ++bj) {
                            f32x4 v0 = acc[ai][bj][m][0], v1 = acc[ai][bj][m][1];
                            if (lat) rope8(v0, v1, RD + ((size_t)pos * 32 + sel * 16 + 8 * (fq & 1)) * 2, first, 32);
                            store8(dst + row * 512 + colb + bj * 128, v0, v1);
                            asm volatile("" ::: "memory");
                        }
                    }
            } else if (pn < 6) {
#pragma unroll
                for (int ai = 0; ai < 2; ++ai)
#pragma unroll
                    for (int m = 0; m < 4; ++m) {
                        const int rl = rl0 + ai * 128 + m * 16; const size_t row = (size_t)u.pm * 256 + rl; const int pos = (tt - 1) * 256 + rl;
#pragma unroll
                        for (int bj = 0; bj < 2; ++bj) {
                            f32x4 v0 = acc[ai][bj][m][0], v1 = acc[ai][bj][m][1];
                            const int c = (pn - 4) * 256 + bj * 128 + wc * 32;
                            if (c < 384) {
                                float ss = v0[0] * v0[0] + v0[1] * v0[1] + v0[2] * v0[2] + v0[3] * v0[3] + v1[0] * v1[0] + v1[1] * v1[1] + v1[2] * v1[2] + v1[3] * v1[3];
                                ss += __shfl_xor(ss, 16); ss += __shfl_xor(ss, 32);
                                if (fq == 0) atomicAdd(rsq + row, ss);
                                store8(PQ + row * 512 + c + 8 * fq, v0, v1);
                            } else if (c == 384) {
                                if (lat) rope8(v0, v1, RM + ((size_t)pos * 16 + (fq >> 1) * 8) * 2, (fq & 1) == 0, 16);
#pragma unroll
                                for (int h = 0; h < 8; ++h) store8(KM + row * 768 + h * 96 + 64 + 8 * fq, v0, v1);
                            }
                            asm volatile("" ::: "memory");
                        }
                    }
            } else if (pn == 6) {
#pragma unroll
                for (int ai = 0; ai < 2; ++ai)
#pragma unroll
                    for (int m = 0; m < 4; ++m) {
                        const size_t row = (size_t)u.pm * 256 + rl0 + ai * 128 + m * 16;
#pragma unroll
                        for (int bj = 0; bj < 2; ++bj) {
                            const f32x4 v0 = acc[ai][bj][m][0], v1 = acc[ai][bj][m][1];
                            float ss = v0[0] * v0[0] + v0[1] * v0[1] + v0[2] * v0[2] + v0[3] * v0[3] + v1[0] * v1[0] + v1[1] * v1[1] + v1[2] * v1[2] + v1[3] * v1[3];
                            ss += __shfl_xor(ss, 16); ss += __shfl_xor(ss, 32);
                            if (fq == 0) atomicAdd(rskv + row, ss);
                            store8(CKV + row * 256 + bj * 128 + wc * 32 + 8 * fq, v0, v1);
                            asm volatile("" ::: "memory");
                        }
                    }
            } else {
                const int colb = (pn - 7) * 256 + wc * 32 + 8 * fq;
#pragma unroll
                for (int ai = 0; ai < 2; ++ai)
#pragma unroll
                    for (int m = 0; m < 4; ++m) {
                        const size_t row = (size_t)u.pm * 256 + rl0 + ai * 128 + m * 16;
#pragma unroll
                        for (int bj = 0; bj < 2; ++bj) {
                            f32x4 v0 = acc[ai][bj][m][0], v1 = acc[ai][bj][m][1];
#pragma unroll
                            for (int i = 0; i < 4; ++i) { v0[i] = sigmoidf_(v0[i]); v1[i] = sigmoidf_(v1[i]); }
                            store8(G + row * 3072 + colb + bj * 128, v0, v1);
                        }
                    }
            }
        } else {
            const int b = u.pn / 9, tt = u.pn % 9, cl = wc * 32 + 8 * fq;
#pragma unroll
            for (int ai = 0; ai < 2; ++ai)
#pragma unroll
                for (int m = 0; m < 4; ++m) {
                    const int r = u.pm * 256 + ai * 128 + wr * 64 + m * 16 + fr;
                    bf16_t* dst;
                    if (u.s == 1) dst = VTD + ((size_t)(b * 4 + (r >> 7)) * 128 + (r & 127)) * TPB + tt * 256;
                    else {
                        const int g = r >> 8, part = (r >> 7) & 1, mm = r & 127;
                        dst = (tt == 0) ? FTC + ((size_t)(b * 512 + g * 128 + mm) * 512 + part * 256)
                                        : FT + ((size_t)(b * 512 + g * 128 + mm) * 4096 + part * 2048 + (tt - 1) * 256);
                    }
#pragma unroll
                    for (int bj = 0; bj < 2; ++bj) store8(dst + bj * 128 + cl, acc[ai][bj][m][0], acc[ai][bj][m][1]);
                }
        }
    }
};
struct EpiUp {
    static constexpr bool PERM = true;
    bf16_t *QM, *KM, *VTM; const float *rsq, *rskv, *RM; int mode;
    DI void operator()(AccRef acc, const Unit& u, int wr, int wc, int fr, int fq) const {
        if (mode == 0) {
            const int tt = u.pm % 9; const bool lat = tt != 0; const int rl0 = wr * 64 + fr;
#pragma unroll
            for (int ai = 0; ai < 2; ++ai)
#pragma unroll
                for (int m = 0; m < 4; ++m) {
                    const int rl = rl0 + ai * 128 + m * 16; const size_t row = (size_t)u.pm * 256 + rl; const int pos = (tt - 1) * 256 + rl;
                    const float rs = __builtin_amdgcn_rsqf(rsq[row] * (1.0f / 384.0f) + RMS_EPS);
#pragma unroll
                    for (int bj = 0; bj < 2; ++bj) {
                        const int c = u.pn * 256 + bj * 128 + wc * 32;
                        f32x4 v0 = acc[ai][bj][m][0] * rs, v1 = acc[ai][bj][m][1] * rs;
                        if (((c >> 5) % 3) == 2 && lat) rope8(v0, v1, RM + ((size_t)pos * 16 + (fq >> 1) * 8) * 2, (fq & 1) == 0, 16);
                        store8(QM + row * 768 + c + 8 * fq, v0, v1);
                    }
                    asm volatile("" ::: "memory");
                }
        } else if (u.s == 0) {
#pragma unroll
            for (int ai = 0; ai < 2; ++ai)
#pragma unroll
                for (int m = 0; m < 4; ++m) {
                    const size_t row = (size_t)u.pm * 256 + wr * 64 + fr + ai * 128 + m * 16;
                    const float rs = __builtin_amdgcn_rsqf(rskv[row] * (1.0f / 256.0f) + RMS_EPS);
#pragma unroll
                    for (int bj = 0; bj < 2; ++bj) {
                        const int c = u.pn * 256 + bj * 128 + wc * 32 + 8 * fq;
                        store8(KM + row * 768 + (c >> 6) * 96 + (c & 63), acc[ai][bj][m][0] * rs, acc[ai][bj][m][1] * rs);
                    }
                    asm volatile("" ::: "memory");
                }
        } else {
            const int b = u.pn / 9, tt = u.pn % 9, cl = wc * 32 + 8 * fq;
#pragma unroll
            for (int bj = 0; bj < 2; ++bj) {
                f32x4 rs[2];
#pragma unroll
                for (int n = 0; n < 2; ++n) {
                    const f32x4 q = *(const f32x4*)(rskv + (size_t)u.pn * 256 + bj * 128 + cl + 4 * n);
#pragma unroll
                    for (int i = 0; i < 4; ++i) rs[n][i] = __builtin_amdgcn_rsqf(q[i] * (1.0f / 256.0f) + RMS_EPS);
                }
#pragma unroll
                for (int ai = 0; ai < 2; ++ai)
#pragma unroll
                    for (int m = 0; m < 4; ++m) {
                        const int r = u.pm * 256 + ai * 128 + wr * 64 + m * 16 + fr;
                        bf16_t* dst = VTM + ((size_t)(b * 8 + (r >> 6)) * 64 + (r & 63)) * TPB + tt * 256;
                        store8(dst + bj * 128 + cl, acc[ai][bj][m][0] * rs[0], acc[ai][bj][m][1] * rs[1]);
                    }
                asm volatile("" ::: "memory");
            }
        }
    }
};
struct EpiF2 {
    static constexpr bool PERM = true;
    bf16_t* Y; int ctx;
    DI void operator()(AccRef acc, const Unit& u, int wr, int wc, int fr, int fq) const {
        const size_t rowb = ctx ? (size_t)u.pm * TPB : (size_t)(u.pm >> 3) * TPB + 256 + (u.pm & 7) * 256;
#pragma unroll
        for (int ai = 0; ai < 2; ++ai)
#pragma unroll
            for (int m = 0; m < 4; ++m) {
                const size_t row = rowb + wr * 64 + fr + ai * 128 + m * 16;
#pragma unroll
                for (int bj = 0; bj < 2; ++bj) store8(Y + row * 1536 + 1024 + u.pn * 256 + bj * 128 + wc * 32 + 8 * fq, acc[ai][bj][m][0], acc[ai][bj][m][1]);
            }
    }
};
struct EpiMerge {
    static constexpr bool PERM = true;
    bf16_t* MG; const bf16_t* G;
    DI void operator()(AccRef acc, const Unit& u, int wr, int wc, int fr, int fq) const {
#pragma unroll
        for (int ai = 0; ai < 2; ++ai)
#pragma unroll
            for (int m = 0; m < 4; ++m) {
                const size_t row = (size_t)u.pm * 256 + wr * 64 + fr + ai * 128 + m * 16;
#pragma unroll
                for (int bj = 0; bj < 2; ++bj) {
                    const int c = u.pn * 256 + bj * 128 + wc * 32 + 8 * fq;
                    f32x4 g0, g1; load8(G + row * 3072 + u.z * 1024 + c, g0, g1);
                    f32x4 v0 = g0 * acc[ai][bj][m][0], v1 = g1 * acc[ai][bj][m][1];
                    if (u.z > 0) { f32x4 p0, p1; load8(MG + row * 1024 + c, p0, p1); v0 += p0; v1 += p1; }
                    store8(MG + row * 1024 + c, v0, v1);
                }
            }
    }
};

#define MFMA32(a, b, c) __builtin_amdgcn_mfma_f32_32x32x16_bf16((a), (b), (c), 0, 0, 0)
template <int D, int DV, bool DIFF>
DI void attn_item(LAS unsigned char* lds, const bf16_t* Qb, int ldq, const bf16_t* Kb, int ldk, const bf16_t* VT, int nkeys, int nq,
                  bf16_t* Yb, float lam, float outfac, const float* subg) {
    constexpr int KROW = (DIFF ? 256 : 192) + 16, VROW = 144, KBYTES = 64 * KROW, VBYTES = DV * VROW, STAGE = KBYTES + VBYTES;
    constexpr int KCH = DIFF ? 16 : 12, NKC = 64 * KCH, NVC = DV * 8, NKK = D / 16, NDVB = DV / 32;
    int tid = threadIdx.x; asm volatile("" : "+v"(tid));
    const int wave = __builtin_amdgcn_readfirstlane(tid >> 6), lane = tid & 63, l32 = lane & 31, half = lane >> 5;
    const float cs = (DIFF ? 0.125f : 0.10206207261596575f) * 1.4426950408889634f;
    const bool active = DIFF ? true : (wave * 64 < nq);
    bf16x8 qf[2][DIFF ? 1 : NKK];
    const LAS unsigned char* qlds = lds + 2 * STAGE + (wave * 32 + l32) * KROW + half * 16;
    if (DIFF) {
#pragma unroll
        for (int i = 0; i < 8; ++i) { const int ch = tid + i * NT, r = ch >> 4, cc = ch & 15;
            *(LAS u32x4*)(lds + 2 * STAGE + r * KROW + cc * 16) = *(const u32x4*)(Qb + (size_t)r * ldq + cc * 8); }
    } else {
#pragma unroll
        for (int s = 0; s < 2; ++s)
#pragma unroll
            for (int kk = 0; kk < NKK; ++kk) {
                const int qr = wave * 64 + s * 32 + l32, qc = kk * 16 + half * 8;
                qf[s][DIFF ? 0 : kk] = active ? *(const bf16x8*)(Qb + (size_t)qr * ldq + qc) : (bf16x8){0, 0, 0, 0, 0, 0, 0, 0};
            }
    }
    f32x16 O[2][NDVB];
#pragma unroll
    for (int s = 0; s < 2; ++s)
#pragma unroll
        for (int d = 0; d < NDVB; ++d)
#pragma unroll
            for (int i = 0; i < 16; ++i) O[s][d][i] = 0.f;
    float mrun[2] = {-1e30f, -1e30f}, lsum[2] = {0.f, 0.f};
    const int nt = nkeys / 64;
    u32x4 kr[2], vr[2];
    const int kc0 = tid, kc1 = tid + NT;
    const bool k1ok = kc1 < NKC, v1ok = (tid + NT) < NVC;
    const int krow0 = kc0 / KCH, kcc0 = kc0 % KCH, krow1 = kc1 / KCH, kcc1 = kc1 % KCH;
    const int vrow0 = tid >> 3, vcc0 = tid & 7, vrow1 = (tid + NT) >> 3;
#define ATT_LOAD(t) do { const int key0 = (t) * 64; \
        kr[0] = *(const u32x4*)(Kb + (size_t)(key0 + krow0) * ldk + kcc0 * 8); \
        if (k1ok) kr[1] = *(const u32x4*)(Kb + (size_t)(key0 + krow1) * ldk + kcc1 * 8); \
        vr[0] = *(const u32x4*)(VT + (size_t)vrow0 * TPB + key0 + vcc0 * 8); \
        if (v1ok) vr[1] = *(const u32x4*)(VT + (size_t)vrow1 * TPB + key0 + vcc0 * 8); } while (0)
#define ATT_WRITE(st) do { LAS unsigned char* sb = lds + (st) * STAGE; \
        *(LAS u32x4*)(sb + krow0 * KROW + kcc0 * 16) = kr[0]; \
        if (k1ok) *(LAS u32x4*)(sb + krow1 * KROW + kcc1 * 16) = kr[1]; \
        *(LAS u32x4*)(sb + KBYTES + vrow0 * VROW + vcc0 * 16) = vr[0]; \
        if (v1ok) *(LAS u32x4*)(sb + KBYTES + vrow1 * VROW + vcc0 * 16) = vr[1]; } while (0)
    ATT_LOAD(0); ATT_WRITE(0); __syncthreads();
    for (int t = 0; t < nt; ++t) {
        if (t + 1 < nt) ATT_LOAD(t + 1);
        if (active) {
            const LAS unsigned char* sb = lds + (t & 1) * STAGE;
#pragma unroll
            for (int kb = 0; kb < 2; ++kb) {
                bf16x8 P[2][2];
                f32x16 S[2];
                if (!DIFF) {
#pragma unroll
                    for (int s = 0; s < 2; ++s)
#pragma unroll
                        for (int i = 0; i < 16; ++i) S[s][i] = 0.f;
#pragma unroll
                    for (int kk = 0; kk < NKK; ++kk) {
                        const bf16x8 kf = *(const LAS bf16x8*)(sb + (kb * 32 + l32) * KROW + (kk * 16 + half * 8) * 2);
                        S[0] = MFMA32(kf, qf[0][DIFF ? 0 : kk], S[0]); S[1] = MFMA32(kf, qf[1][DIFF ? 0 : kk], S[1]);
                    }
                }
#pragma unroll
                for (int s = 0; s < 2; ++s) {
                    if (DIFF) {
#pragma unroll
                        for (int i = 0; i < 16; ++i) S[s][i] = 0.f;
#pragma unroll
                        for (int kk = 0; kk < NKK; ++kk) {
                            const bf16x8 kf = *(const LAS bf16x8*)(sb + (kb * 32 + l32) * KROW + (s * 64 + kk * 16 + half * 8) * 2);
                            const bf16x8 qq = *(const LAS bf16x8*)(qlds + (s * 64 + kk * 16) * 2);
                            S[s] = MFMA32(kf, qq, S[s]);
                        }
                    }
                    float mx = S[s][0];
#pragma unroll
                    for (int i = 1; i < 16; ++i) mx = fmaxf(mx, S[s][i]);
                    mx = fmaxf(mx, __shfl_xor(mx, 32));
                    const float mt2 = mx * cs;
                    if (__builtin_amdgcn_ballot_w64(mt2 > mrun[s] + 8.0f) != 0ull) {
                        const float mnew = fmaxf(mrun[s], mt2), alpha = fast_exp2(mrun[s] - mnew);
                        lsum[s] *= alpha;
#pragma unroll
                        for (int d = 0; d < NDVB; ++d)
#pragma unroll
                            for (int i = 0; i < 16; ++i) O[s][d][i] *= alpha;
                        mrun[s] = mnew;
                    }
                    float ls = 0.f;
#pragma unroll
                    for (int i = 0; i < 16; ++i) { S[s][i] = fast_exp2(S[s][i] * cs - mrun[s]); ls += S[s][i]; }
                    lsum[s] += ls;
#pragma unroll
                    for (int k2 = 0; k2 < 2; ++k2) {
                        u32x4 w = {pk2(S[s][8 * k2], S[s][8 * k2 + 1]), pk2(S[s][8 * k2 + 2], S[s][8 * k2 + 3]), pk2(S[s][8 * k2 + 4], S[s][8 * k2 + 5]), pk2(S[s][8 * k2 + 6], S[s][8 * k2 + 7])};
                        P[s][k2] = __builtin_bit_cast(bf16x8, w);
                    }
                    if (DIFF) asm volatile("" ::: "memory");
                }
#pragma unroll
                for (int d = 0; d < NDVB; ++d)
#pragma unroll
                    for (int k2 = 0; k2 < 2; ++k2) {
                        const LAS unsigned char* va = sb + KBYTES + (d * 32 + l32) * VROW + (kb * 32 + k2 * 16 + half * 4) * 2;
                        const u32x2 lo = *(const LAS u32x2*)va, hi = *(const LAS u32x2*)(va + 16);
                        const u32x4 w = {lo.x, lo.y, hi.x, hi.y};
                        const bf16x8 vf = __builtin_bit_cast(bf16x8, w);
                        O[0][d] = MFMA32(vf, P[0][k2], O[0][d]); O[1][d] = MFMA32(vf, P[1][k2], O[1][d]);
                        if (DIFF) asm volatile("" ::: "memory");
                    }
            }
        }
        if (t + 1 < nt) ATT_WRITE((t + 1) & 1);
        __syncthreads();
    }
#undef ATT_LOAD
#undef ATT_WRITE
    if (!active) return;
    int l32e = l32, halfe = half; asm volatile("" : "+v"(l32e), "+v"(halfe));
    float inv[2];
#pragma unroll
    for (int s = 0; s < 2; ++s) { const float l = lsum[s] + __shfl_xor(lsum[s], 32); inv[s] = 1.0f / l; }
    if (DIFF) {
        float ss = 0.f;
#pragma unroll
        for (int d = 0; d < NDVB; ++d)
#pragma unroll
            for (int i = 0; i < 16; ++i) { const float o = O[0][d][i] * inv[0] - lam * (O[1][d][i] * inv[1]); O[0][d][i] = o; ss += o * o; }
        ss += __shfl_xor(ss, 32);
        const float rs = __builtin_amdgcn_rsqf(ss * (1.0f / 128.0f) + RMS_EPS) * outfac;
        bf16_t* yr = Yb + (size_t)(wave * 32 + l32e) * 1536;
#pragma unroll
        for (int d = 0; d < NDVB; ++d)
#pragma unroll
            for (int g4 = 0; g4 < 4; ++g4) {
                const int dv = d * 32 + g4 * 8 + halfe * 4;
                const f32x4 gg = *(const f32x4*)(subg + dv);
                u32x2 w = {pk2(O[0][d][4 * g4] * rs * gg[0], O[0][d][4 * g4 + 1] * rs * gg[1]), pk2(O[0][d][4 * g4 + 2] * rs * gg[2], O[0][d][4 * g4 + 3] * rs * gg[3])};
                *(u32x2*)(yr + dv) = w;
            }
    } else {
#pragma unroll
        for (int s = 0; s < 2; ++s) {
            bf16_t* yr = Yb + (size_t)(wave * 64 + s * 32 + l32e) * 1536;
#pragma unroll
            for (int d = 0; d < NDVB; ++d)
#pragma unroll
                for (int g4 = 0; g4 < 4; ++g4) {
                    const int dv = d * 32 + g4 * 8 + halfe * 4;
                    u32x2 w = {pk2(O[s][d][4 * g4] * inv[s], O[s][d][4 * g4 + 1] * inv[s]), pk2(O[s][d][4 * g4 + 2] * inv[s], O[s][d][4 * g4 + 3] * inv[s])};
                    *(u32x2*)(yr + dv) = w;
                }
        }
    }
}

DI int mapcol(int kind, int n) {
    switch (kind) {
        case 1: { const int pn = n >> 8, r = n & 255; return r < 128 ? pn * 128 + r : DFF + pn * 128 + (r - 128); }
        case 2: return n < 1024 ? n : n < 1408 ? 1536 + (n - 1024) : n < 1440 ? 2176 + (n - 1408) : n < 1536 ? -1 : n < 1792 ? 1920 + (n - 1536) : 2720 + (n - 1792);
        case 3: return 1024 + n;
        case 4: return (n >> 6) * 128 + (n & 63);
        case 5: return (n >> 6) * 128 + 64 + (n & 63);
        default: return n;
    }
}
DI void prepT(LAS float* tile, bf16_t* dst, const float* src, int lds_, int Kd, int Nd, int kind, const float* kscale, int& rot) {
    int tid = threadIdx.x; asm volatile("" : "+v"(tid));
    const int G = gridDim.x, ntk = Kd >> 6, ntiles = ntk * (Nd >> 6);
    for (int t = (int)((blockIdx.x + (unsigned)G - (unsigned)(rot % G)) % (unsigned)G); t < ntiles; t += G) {
        const int k0 = (t % ntk) << 6, n0 = (t / ntk) << 6;
        const int nn = tid & 63, sc = mapcol(kind, n0 + nn);
#pragma unroll
        for (int ps = 0; ps < 8; ++ps) {
            const int kk = ps * 8 + (tid >> 6);
            float v = sc >= 0 ? src[(size_t)(k0 + kk) * lds_ + sc] : 0.f;
            if (kscale) v *= kscale[k0 + kk];
            tile[kk * 65 + nn] = v;
        }
        __syncthreads();
        const int on = tid >> 3, kc = tid & 7;
        u32x4 w;
        w.x = pk2(tile[(kc * 8 + 0) * 65 + on], tile[(kc * 8 + 1) * 65 + on]); w.y = pk2(tile[(kc * 8 + 2) * 65 + on], tile[(kc * 8 + 3) * 65 + on]);
        w.z = pk2(tile[(kc * 8 + 4) * 65 + on], tile[(kc * 8 + 5) * 65 + on]); w.w = pk2(tile[(kc * 8 + 6) * 65 + on], tile[(kc * 8 + 7) * 65 + on]);
        *(u32x4*)(dst + (size_t)(n0 + on) * Kd + k0 + kc * 8) = w;
        __syncthreads();
    }
    rot += ntiles;
}

DI void prologue(const Params& p, LAS unsigned char* lds) {
    int tid = threadIdx.x; asm volatile("" : "+v"(tid));
    const int G = gridDim.x, bid = blockIdx.x;
    const size_t gtid = (size_t)bid * NT + tid, gsz = (size_t)G * NT;
    unsigned char* ws = p.ws;
    {
        f32x4* H = (f32x4*)(ws + OFF_H);
        for (size_t i = gtid; i < (size_t)T * 256; i += gsz) {
            const int t = (int)(i >> 8), c4 = (int)(i & 255), b = t / TPB, r = t - b * TPB;
            H[i] = r < CTX ? ((const f32x4*)p.ctx)[((size_t)b * CTX + r) * 256 + c4] : ((const f32x4*)p.x)[((size_t)b * SEQ + (r - CTX)) * 256 + c4];
        }
    }
    {
        float* RD = (float*)(ws + OFF_ROPED); float* RM = (float*)(ws + OFF_ROPEM);
        for (size_t i = gtid; i < (size_t)2048 * 32; i += gsz) {
            const int pos = (int)(i >> 5), e = (int)(i & 31), sel = e >> 4, j = e & 15;
            const float fr = __powf(10000.f, -(float)j / 16.f), ang = (float)(sel ? (pos & 63) : (pos >> 6)) * fr, rev = ang * 0.15915494309189535f;
            RD[2 * i] = __builtin_amdgcn_cosf(rev); RD[2 * i + 1] = __builtin_amdgcn_sinf(rev);
        }
        for (size_t i = gtid; i < (size_t)2048 * 16; i += gsz) {
            const int pos = (int)(i >> 4), e = (int)(i & 15), sel = e >> 3, j = e & 7;
            const float fr = __powf(10000.f, -(float)j / 8.f), ang = (float)(sel ? (pos & 63) : (pos >> 6)) * fr, rev = ang * 0.15915494309189535f;
            RM[2 * i] = __builtin_amdgcn_cosf(rev); RM[2 * i + 1] = __builtin_amdgcn_sinf(rev);
        }
    }
    {
        u32x4* DL = (u32x4*)(ws + OFF_DFTL);
        for (size_t i = gtid; i < (size_t)2048 * 512; i += gsz) {
            const int k = (int)(i >> 9), c8 = (int)(i & 511) * 8, part = c8 >> 11, n0 = c8 & 2047;
            float v[8];
#pragma unroll
            for (int j = 0; j < 8; ++j) { const float fr = (float)((k * (n0 + j)) & 2047) * (1.0f / 2048.0f);
                v[j] = (part ? -__builtin_amdgcn_sinf(fr) : __builtin_amdgcn_cosf(fr)) * 0.022097086912079608f; }
            DL[i] = (u32x4){pk2(v[0], v[1]), pk2(v[2], v[3]), pk2(v[4], v[5]), pk2(v[6], v[7])};
        }
        u32x4* DC = (u32x4*)(ws + OFF_DFTC);
        for (size_t i = gtid; i < (size_t)256 * 64; i += gsz) {
            const int k = (int)(i >> 6), c8 = (int)(i & 63) * 8, part = c8 >> 8, n0 = c8 & 255;
            float v[8];
#pragma unroll
            for (int j = 0; j < 8; ++j) { const float fr = (float)((k * (n0 + j)) & 255) * (1.0f / 256.0f);
                v[j] = (part ? -__builtin_amdgcn_sinf(fr) : __builtin_amdgcn_cosf(fr)) * 0.0625f; }
            DC[i] = (u32x4){pk2(v[0], v[1]), pk2(v[2], v[3]), pk2(v[4], v[5]), pk2(v[6], v[7])};
        }
    }
    if (bid == 0 && tid < DEPTH) {
        const float* dl = p.diff_lambda + tid * 4 * 64; float a = 0.f, b = 0.f;
        for (int i = 0; i < 64; ++i) { a += dl[i] * dl[64 + i]; b += dl[128 + i] * dl[192 + i]; }
        const float lam_init = 0.8f - 0.6f * expf(-0.3f * (float)tid);
        ((float*)(ws + OFF_LAM))[tid] = expf(a) - expf(b) + lam_init;
        ((float*)(ws + OFF_LAM))[4 + tid] = 1.0f - lam_init;
    }
    {
        LAS float* sc = (LAS float*)lds;
        LAS float* red = (LAS float*)(lds + 40960);
        for (int i = tid; i < 9 * 1024; i += NT) { const float v = i < 8192 ? p.c[i] : p.c_ctx[i - 8192]; sc[i] = v * sigmoidf_(v); }
        __syncthreads();
        float* MOD = (float*)(ws + OFF_MOD);
        for (int it = bid; it < DEPTH * 144; it += G) {
            const int l = it / 144, n0 = (it % 144) * 64, col = tid & 63, kg = tid >> 6;
            const float* w = p.ada_w + (size_t)l * 1024 * 9216 + n0 + col;
            float a[9];
#pragma unroll
            for (int r = 0; r < 9; ++r) a[r] = 0.f;
            for (int k = kg * 128; k < kg * 128 + 128; ++k) {
                const float wv = w[(size_t)k * 9216];
#pragma unroll
                for (int r = 0; r < 9; ++r) a[r] += sc[r * 1024 + k] * wv;
            }
#pragma unroll
            for (int r = 0; r < 9; ++r) red[(kg * 9 + r) * 64 + col] = a[r];
            __syncthreads();
            for (int o = tid; o < 576; o += NT) {
                const int r = o >> 6, cc = o & 63; float s = p.ada_b[l * 9216 + n0 + cc];
#pragma unroll
                for (int g = 0; g < 8; ++g) s += red[(g * 9 + r) * 64 + cc];
                MOD[((size_t)l * 9 + r) * 9216 + n0 + cc] = s;
            }
            __syncthreads();
        }
    }
    {
        LAS float* wt = (LAS float*)lds;
        LAS float* tc = (LAS float*)(lds + 16384);
        LAS bf16_t* ot = (LAS bf16_t*)(lds + 20480);
        for (int i = tid; i < 128; i += NT) { tc[i] = __builtin_amdgcn_cosf((float)i * (1.0f / 128.0f)); tc[128 + i] = __builtin_amdgcn_sinf((float)i * (1.0f / 128.0f)); }
        for (int it = bid; it < DEPTH * 4 * 32; it += G) {
            const int l = it >> 7, g = (it >> 5) & 3, k0 = (it & 31) * 32;
            __syncthreads();
            for (int i = tid; i < 32 * 128; i += NT) wt[i] = p.w_in[((size_t)l * 1024 + k0 + (i >> 7)) * INW + 2208 + g * 128 + (i & 127)];
            __syncthreads();
            const int pmi = tid & 255, part = pmi >> 7, m = pmi & 127, kh = tid >> 8;
            float a[16];
#pragma unroll
            for (int i = 0; i < 16; ++i) a[i] = 0.f;
            for (int c = 0; c < 128; ++c) {
                const float tv = tc[part * 128 + ((m * c) & 127)];
#pragma unroll
                for (int i = 0; i < 16; ++i) a[i] += wt[(2 * i + kh) * 128 + c] * tv;
            }
#pragma unroll
            for (int i = 0; i < 16; ++i) { const unsigned w = pk2(a[i] * 0.08838834764831845f, 0.f); ot[pmi * 32 + 2 * i + kh] = (bf16_t)(w & 0xffffu); }
            __syncthreads();
            bf16_t* AF = (bf16_t*)(ws + OFF_W) + (size_t)l * WE_END + WE_F;
            for (int ch = tid; ch < 1024; ch += NT) {
                const int r = ch >> 2, q = ch & 3;
                *(u32x4*)(AF + (size_t)(g * 256 + r) * 1024 + k0 + q * 8) = *(const LAS u32x4*)(ot + r * 32 + q * 8);
            }
        }
        __syncthreads();
    }
    {
        LAS float* tile = (LAS float*)lds; int rot = 0;
        for (int l = 0; l < DEPTH; ++l) {
            bf16_t* W = (bf16_t*)(ws + OFF_W) + (size_t)l * WE_END;
            for (int s = 0; s < 2; ++s) {
                prepT(tile, W + WE_W1 + (size_t)s * 5632 * 1024, p.ffn_w_in + ((size_t)l * 2 + s) * 1024 * 5632, 5632, 1024, 5632, 1, nullptr, rot);
                prepT(tile, W + WE_W2 + (size_t)s * 1024 * 2816, p.ffn_w_out + ((size_t)l * 2 + s) * 2816 * 1024, 1024, 2816, 1024, 0, nullptr, rot);
            }
            const float* win = p.w_in + (size_t)l * 1024 * INW;
            prepT(tile, W + WE_IN, win, INW, 1024, 4864, 2, nullptr, rot);
            prepT(tile, W + WE_V, win, INW, 1024, 512, 3, nullptr, rot);
            prepT(tile, W + WE_UQ, p.mla_w_uq + (size_t)l * 384 * 768, 768, 384, 768, 0, p.mla_q_norm_g + l * 384, rot);
            prepT(tile, W + WE_UK, p.mla_w_ukv + (size_t)l * 256 * 1024, 1024, 256, 512, 4, p.mla_kv_norm_g + l * 256, rot);
            prepT(tile, W + WE_UV, p.mla_w_ukv + (size_t)l * 256 * 1024, 1024, 256, 512, 5, p.mla_kv_norm_g + l * 256, rot);
            prepT(tile, W + WE_B, p.w_bd + (size_t)l * 512 * 1024, 1024, 512, 1024, 0, nullptr, rot);
            prepT(tile, W + WE_B + (size_t)1024 * 512, p.w_bm + (size_t)l * 512 * 1024, 1024, 512, 1024, 0, nullptr, rot);
            prepT(tile, W + WE_B + (size_t)2 * 1024 * 512, p.w_bf + (size_t)l * 512 * 1024, 1024, 512, 1024, 0, nullptr, rot);
            prepT(tile, W + WE_O, p.w_out + (size_t)l * 1024 * 1024, 1024, 1024, 1024, 0, nullptr, rot);
        }
    }
}

DI void norm_phase(const Params& p, const float* gain, const float* modl, int sh_i, int sc_i, bool zero) {
    int tid = threadIdx.x; asm volatile("" : "+v"(tid));
    const int lane = tid & 63, gw = blockIdx.x * 8 + (tid >> 6), nw = gridDim.x * 8;
    const float* H = (const float*)(p.ws + OFF_H); bf16_t* AN = (bf16_t*)(p.ws + OFF_AN);
    for (int t = gw; t < T; t += nw) {
        const f32x4* hr = (const f32x4*)(H + (size_t)t * DM);
        f32x4 v[4]; float ss = 0.f;
#pragma unroll
        for (int j = 0; j < 4; ++j) { v[j] = hr[lane + 64 * j]; ss += v[j][0] * v[j][0] + v[j][1] * v[j][1] + v[j][2] * v[j][2] + v[j][3] * v[j][3]; }
        ss = wave_sum(ss);
        const float rs = __builtin_amdgcn_rsqf(ss * (1.0f / 1024.0f) + RMS_EPS);
        const int b = t / TPB, r = t - b * TPB, mrow = r < CTX ? 8 : b;
        const float* sh = modl + (size_t)mrow * 9216 + sh_i * 1024; const float* sc = modl + (size_t)mrow * 9216 + sc_i * 1024;
#pragma unroll
        for (int j = 0; j < 4; ++j) {
            const int c = (lane + 64 * j) * 4;
            const f32x4 g = *(const f32x4*)(gain + c), s1 = *(const f32x4*)(sc + c), s0 = *(const f32x4*)(sh + c);
            const f32x4 y = (v[j] * rs * g) * (s1 + 1.0f) + s0;
            *(u32x2*)(AN + (size_t)t * DM + c) = (u32x2){pk2(y[0], y[1]), pk2(y[2], y[3])};
        }
    }
    if (zero) {
        float* a = (float*)(p.ws + OFF_RSQ);
        for (size_t i = (size_t)blockIdx.x * NT + tid; i < (size_t)2 * T; i += (size_t)gridDim.x * NT) a[i] = 0.f;
    }
}
DI void final_phase(const Params& p) {
    int tid = threadIdx.x; asm volatile("" : "+v"(tid));
    const int lane = tid & 63, gw = blockIdx.x * 8 + (tid >> 6), nw = gridDim.x * 8;
    const float* H = (const float*)(p.ws + OFF_H);
    for (int q = gw; q < NB * SEQ; q += nw) {
        const int b = q >> 11, n = q & 2047;
        const f32x4* hr = (const f32x4*)(H + ((size_t)b * TPB + CTX + n) * DM);
        f32x4 v[4]; float ss = 0.f;
#pragma unroll
        for (int j = 0; j < 4; ++j) { v[j] = hr[lane + 64 * j]; ss += v[j][0] * v[j][0] + v[j][1] * v[j][1] + v[j][2] * v[j][2] + v[j][3] * v[j][3]; }
        ss = wave_sum(ss);
        const float rs = __builtin_amdgcn_rsqf(ss * (1.0f / 1024.0f) + RMS_EPS);
#pragma unroll
        for (int j = 0; j < 4; ++j) { const int c = (lane + 64 * j) * 4; *(f32x4*)(p.out + (size_t)q * DM + c) = v[j] * rs * *(const f32x4*)(p.final_g + c); }
    }
}

constexpr int NPH = 2 + 12 * DEPTH;
#ifndef PH_MASK
#define PH_MASK 0xffff
#endif
#define EN(k) (((PH_MASK) >> (k)) & 1)
#ifndef ATT_MASK
#define ATT_MASK 0xf
#endif
#define AEN(k) (((ATT_MASK) >> (k)) & 1)
__global__ void __launch_bounds__(NT, 2) fwd_kernel(Params p) {
    extern __shared__ __attribute__((aligned(16))) unsigned char shm[];
    LAS unsigned char* lds = (LAS unsigned char*)shm;
    const int G = gridDim.x, bid = blockIdx.x;
    for (int ph = p.ph_lo; ph < p.ph_hi; ++ph) {
        unsigned char* ws = p.ws; asm volatile("" : "+s"(ws));
        float* H = (float*)(ws + OFF_H); bf16_t* AN = (bf16_t*)(ws + OFF_AN); bf16_t* MG = AN;
        bf16_t* ACT = (bf16_t*)(ws + OFF_R1); bf16_t* GT = (bf16_t*)(ws + OFF_R1);
        bf16_t* QD = (bf16_t*)(ws + OFF_QD); bf16_t* KD = (bf16_t*)(ws + OFF_KD); bf16_t* VTD = (bf16_t*)(ws + OFF_VTD);
        bf16_t* FT = (bf16_t*)(ws + OFF_FT); bf16_t* FTC = (bf16_t*)(ws + OFF_FTC);
        bf16_t* QM = (bf16_t*)(ws + OFF_QM); bf16_t* KM = (bf16_t*)(ws + OFF_KM); bf16_t* VTM = (bf16_t*)(ws + OFF_VTM);
        bf16_t* Y = (bf16_t*)(ws + OFF_Y); bf16_t* PQ = (bf16_t*)(ws + OFF_PQ); bf16_t* CKV = (bf16_t*)(ws + OFF_CKV);
        float* RSQ = (float*)(ws + OFF_RSQ); float* RSKV = (float*)(ws + OFF_RSKV);
        const float* RD = (const float*)(ws + OFF_ROPED); const float* RM = (const float*)(ws + OFF_ROPEM);
        const float* LAM = (const float*)(ws + OFF_LAM);
        const bf16_t* DFTL = (const bf16_t*)(ws + OFF_DFTL); const bf16_t* DFTC = (const bf16_t*)(ws + OFF_DFTC);

        if (ph == 0) { if (EN(12)) prologue(p, lds); }
        else if (ph == NPH - 1) { if (EN(13)) final_phase(p); }
        else {
            const int l = (ph - 1) / 12, sp = (ph - 1) % 12;
            const float* modl = (const float*)(ws + OFF_MOD) + (size_t)l * 9 * 9216;
            const bf16_t* W = (const bf16_t*)(ws + OFF_W) + (size_t)l * WE_END;
            pg8::Sched S; S.ns = 1; S.G = G; S.c = bid; S.rep = 1; S.za = 0; S.zb = 0;
            if (EN(0) && (sp == 0 || sp == 3 || sp == 9)) {
                const int ni = sp == 0 ? 0 : sp == 3 ? 1 : 2;
                norm_phase(p, p.norm_g + ((size_t)l * 3 + ni) * DM, modl, 3 * ni, 3 * ni + 1, sp == 3);
            } else if (EN(1) && (sp == 1 || sp == 10)) {
                const int s = sp == 1 ? 0 : 1;
                S.s0 = pg8::mksub(AN, W + WE_W1 + (size_t)s * 5632 * 1024, 72, 22, 1024, 1024);
                EpiSwiglu E{ACT};
                pg8::gemm_phase(lds, 1024, 1024, 1024, S, E);
            } else if (EN(2) && (sp == 2 || sp == 11)) {
                const int s = sp == 2 ? 0 : 1;
                S.s0 = pg8::mksub(ACT, W + WE_W2 + (size_t)s * 1024 * 2816, 72, 4, 2816, 2816);
                EpiResid E{H, modl, s == 0 ? 2 : 8, 0.5f};
                pg8::gemm_phase(lds, 2816, 2816, 2816, S, E);
            } else if (EN(4) && sp == 4) {
                S.ns = 3;
                S.s0 = pg8::mksub(AN, W + WE_IN, 72, 19, 1024, 1024);
                S.s1 = pg8::mksub(W + WE_V, AN, 2, 72, 1024, 1024);
                S.s2 = pg8::mksub(W + WE_F, AN, 4, 72, 1024, 1024);
                EpiIn E{QD, KD, PQ, CKV, GT, KM, VTD, FT, FTC, RSQ, RSKV, RD, RM};
                pg8::gemm_phase(lds, 1024, 1024, 1024, S, E);
            } else if (EN(5) && sp == 5) {
                for (int cx = 0; cx < 2; ++cx) {
                    S.ns = cx ? 2 : 1; S.c = cx ? (bid + 216) % G : bid;
                    S.s0 = cx ? pg8::mksub(CKV, W + WE_UK, 72, 2, 256, 256) : pg8::mksub(PQ, W + WE_UQ, 72, 3, 512, 384);
                    S.s1 = pg8::mksub(W + WE_UV, CKV, 2, 72, 256, 256);
                    EpiUp E{QM, KM, VTM, RSQ, RSKV, RM, cx};
                    pg8::gemm_phase(lds, cx ? 256 : 384, cx ? 256 : 512, cx ? 256 : 384, S, E);
                }
            } else if (EN(6) && sp == 6) {
                const float lam = LAM[l], outfac = LAM[4 + l];
                if (AEN(0)) for (int i0 = bid; i0 < 288; i0 += G) {
                    const bool lat = i0 < 256; const int it = lat ? ((G == 256) ? ((i0 & 7) * 32 + (i0 >> 3)) : i0) : i0 - 256;
                    const int b = lat ? it >> 5 : it >> 2, h = lat ? (it >> 3) & 3 : it & 3, qt = it & 7;
                    const size_t rb = (size_t)b * TPB, r0 = lat ? rb + CTX + qt * 256 : rb;
                    attn_item<64, 128, true>(lds, QD + r0 * 512 + h * 128, 512, KD + rb * 512 + h * 128, 512, VTD + (size_t)(b * 4 + h) * 128 * TPB, lat ? TPB : CTX, 256,
                                             Y + r0 * 1536 + h * 128, lam, outfac, p.diff_subln_g + l * 128);
                }
                if (AEN(1)) for (int i1 = bid; i1 < 320; i1 += G) {
                    const int i0 = (i1 + 32) % 320;
                    const bool lat = i0 < 256; const int it = lat ? ((G == 256) ? ((i0 & 7) * 32 + (i0 >> 3)) : i0) : i0 - 256;
                    const int b = lat ? it >> 5 : it >> 3, h = lat ? (it >> 2) & 7 : it & 7, qt = it & 3;
                    const size_t rb = (size_t)b * TPB, r0 = lat ? rb + CTX + qt * 512 : rb;
                    attn_item<96, 64, false>(lds, QM + r0 * 768 + h * 96, 768, KM + rb * 768 + h * 96, 768, VTM + (size_t)(b * 8 + h) * 64 * TPB, lat ? TPB : CTX, lat ? 512 : 256,
                                             Y + r0 * 1536 + 512 + h * 64, 0.f, 1.f, nullptr);
                }
                __syncthreads();
                if (AEN(3)) for (int cx = 0; cx < 2; ++cx) {
                    const int Kf = cx ? 512 : 4096;
                    S.c = cx ? bid : (bid + 128) % G;
                    S.s0 = pg8::mksub(cx ? DFTC : DFTL, cx ? FTC : FT, cx ? 8 : 64, 2, Kf, Kf); S.s0.mmod = cx ? 1 : 8; S.s0.zb = (size_t)512 * Kf * 2;
                    EpiF2 E1{Y, cx};
                    pg8::gemm_phase(lds, Kf, Kf, Kf, S, E1);
                }
            } else if (EN(7) && sp == 7) {
                S.rep = 3; S.za = 512 * 2; S.zb = (size_t)1024 * 512 * 2;
                S.s0 = pg8::mksub(Y, W + WE_B, 72, 4, 1536, 512);
                EpiMerge E{MG, GT};
                pg8::gemm_phase(lds, 512, 1536, 512, S, E);
            } else if (EN(8) && sp == 8) {
                S.s0 = pg8::mksub(MG, W + WE_O, 72, 4, 1024, 1024);
                EpiResid E{H, modl, 5, 1.0f};
                pg8::gemm_phase(lds, 1024, 1024, 1024, S, E);
            }
        }
        if (ph + 1 < p.ph_hi) cg::this_grid().sync();
    }
}

extern "C" void kernel_launch(void* const* d_in, const int* in_sizes, int n_in, void* d_out, int out_size, void* d_ws, size_t ws_size, hipStream_t stream) {
    static int grid = 0;
    if (grid == 0) {
        if (ws_size < WS_NEED) { fprintf(stderr, "kernel_launch: workspace too small: need %zu have %zu\n", (size_t)WS_NEED, ws_size); grid = -1; return; }
        int dev = 0, cus = 0, per_cu = 0;
        hipGetDevice(&dev); hipDeviceGetAttribute(&cus, hipDeviceAttributeMultiprocessorCount, dev);
        if (hipFuncSetAttribute((const void*)fwd_kernel, hipFuncAttributeMaxDynamicSharedMemorySize, LDS_BYTES) != hipSuccess) { fprintf(stderr, "kernel_launch: hipFuncSetAttribute failed\n"); grid = -1; return; }
        if (hipOccupancyMaxActiveBlocksPerMultiprocessor(&per_cu, (const void*)fwd_kernel, NT, LDS_BYTES) != hipSuccess || per_cu < 1) { fprintf(stderr, "kernel_launch: occupancy query says %d\n", per_cu); per_cu = 1; }
        (void)hipGetLastError();
        grid = cus * per_cu;
        fprintf(stderr, "kernel_launch: grid %d (cus %d x %d), ws need %zu have %zu\n", grid, cus, per_cu, (size_t)WS_NEED, ws_size);
    }
    if (grid < 0) return;
    Params p{};
    const float** pp = (const float**)&p;
    for (int i = 0; i < 21; ++i) pp[i] = (const float*)d_in[i];
    p.out = (float*)d_out; p.ws = (unsigned char*)d_ws;
#if ONE_LAUNCH
    p.ph_lo = 0; p.ph_hi = NPH;
    void* args[] = {&p};
    hipError_t e = hipLaunchCooperativeKernel((const void*)fwd_kernel, dim3(grid), dim3(NT), args, LDS_BYTES, stream);
    if (e != hipSuccess) fprintf(stderr, "cooperative launch failed: %s (grid %d)\n", hipGetErrorString(e), grid);
#else
    for (int ph = 0; ph < NPH; ++ph) {
        p.ph_lo = ph; p.ph_hi = ph + 1;
        hipLaunchKernelGGL(fwd_kernel, dim3(grid), dim3(NT), LDS_BYTES, stream, p);
    }
#endif
}
```

```cpp
#include <hip/hip_runtime.h>
#include <hip/hip_cooperative_groups.h>
#include <cstdio>
namespace cg = cooperative_groups;

#define REPS(ph) 1
#ifndef ONE_LAUNCH
#define ONE_LAUNCH 1
#endif

#define LAS __attribute__((address_space(3)))
#define DI __device__ __forceinline__
typedef unsigned short bf16_t;
typedef short bf16x8 __attribute__((ext_vector_type(8)));
typedef float f32x4 __attribute__((ext_vector_type(4)));
typedef float f32x16 __attribute__((ext_vector_type(16)));
typedef unsigned u32x4 __attribute__((ext_vector_type(4)));
typedef unsigned u32x2 __attribute__((ext_vector_type(2)));

constexpr int DM = 1024, NB = 8, SEQ = 2048, CTX = 256, TPB = SEQ + CTX  , T = NB * TPB  ;
constexpr int DEPTH = 4, DFF = 2816, INW = 5792, NMOD = 9;
constexpr int NT = 512;
constexpr int LDS_MAIN = 147456;
constexpr int LDS_BYTES = LDS_MAIN + 256;
constexpr float RMS_EPS = 1e-6f;

constexpr size_t al256(size_t x) { return (x + 255) & ~(size_t)255; }
constexpr size_t OFF_H = 0;
constexpr size_t OFF_AN = OFF_H + (size_t)T * DM * 4;
constexpr size_t OFF_R1 = OFF_AN + (size_t)T * DM * 2;
constexpr size_t OFF_QD = OFF_R1 + (size_t)T * 3072 * 2;
constexpr size_t OFF_KD = OFF_QD + (size_t)T * 512 * 2;
constexpr size_t OFF_VTD = OFF_KD + (size_t)T * 512 * 2;
constexpr size_t OFF_FT = OFF_VTD + (size_t)T * 512 * 2;
constexpr size_t OFF_FTC = OFF_FT + (size_t)NB * 512 * 4096 * 2;
constexpr size_t OFF_QM = OFF_FTC + (size_t)NB * 512 * 512 * 2;
constexpr size_t OFF_KM = OFF_QM + (size_t)T * 768 * 2;
constexpr size_t OFF_VTM = OFF_KM + (size_t)T * 768 * 2;
constexpr size_t OFF_Y = OFF_VTM + (size_t)T * 512 * 2;
constexpr size_t OFF_PQ = OFF_Y;
constexpr size_t OFF_CKV = OFF_PQ + (size_t)T * 512 * 2;
constexpr size_t OFF_RSQ = OFF_Y + (size_t)T * 1536 * 2;
constexpr size_t OFF_RSKV = OFF_RSQ + (size_t)T * 4;
constexpr size_t OFF_MOD = OFF_RSKV + (size_t)T * 4;
constexpr size_t OFF_ROPED = OFF_MOD + (size_t)DEPTH * 9 * 9216 * 4;
constexpr size_t OFF_ROPEM = OFF_ROPED + (size_t)2048 * 32 * 8;
constexpr size_t OFF_LAM = OFF_ROPEM + (size_t)2048 * 16 * 8;
constexpr size_t OFF_DFTL = OFF_LAM + 256;
constexpr size_t OFF_DFTC = OFF_DFTL + (size_t)2048 * 4096 * 2;
constexpr size_t OFF_W = OFF_DFTC + (size_t)256 * 512 * 2;
constexpr size_t WE_W1 = 0;
constexpr size_t WE_W2 = WE_W1 + (size_t)2 * 5632 * 1024;
constexpr size_t WE_IN = WE_W2 + (size_t)2 * 1024 * 2816;
constexpr size_t WE_V = WE_IN + (size_t)4864 * 1024;
constexpr size_t WE_F = WE_V + (size_t)512 * 1024;
constexpr size_t WE_UQ = WE_F + (size_t)1024 * 1024;
constexpr size_t WE_UK = WE_UQ + (size_t)768 * 384;
constexpr size_t WE_UV = WE_UK + (size_t)512 * 256;
constexpr size_t WE_B = WE_UV + (size_t)512 * 256;
constexpr size_t WE_O = WE_B + (size_t)3 * 1024 * 512;
constexpr size_t WE_END = WE_O + (size_t)1024 * 1024;
constexpr size_t OFF_BAR = OFF_W + (size_t)DEPTH * WE_END * 2;
constexpr size_t BAR_BYTES = 3456 * 4;
constexpr size_t WS_NEED = OFF_BAR + BAR_BYTES;

struct Params {
    const float *x, *c, *ctx, *c_ctx, *ada_w, *ada_b, *norm_g, *ffn_w_in, *ffn_w_out, *w_in, *diff_lambda, *diff_subln_g, *mla_q_norm_g, *mla_w_uq,
        *mla_kv_norm_g, *mla_w_ukv, *w_bd, *w_bm, *w_bf, *w_out, *final_g;
    float* out; unsigned char* ws; int ph_lo, ph_hi;
};

DI unsigned pk2(float a, float b) {
    typedef float f2 __attribute__((ext_vector_type(2))); typedef __bf16 b2 __attribute__((ext_vector_type(2)));
    f2 v = {a, b}; b2 r = __builtin_convertvector(v, b2); return __builtin_bit_cast(unsigned, r);
}
DI float bflo(unsigned w) { return __uint_as_float(w << 16); }
DI float bfhi(unsigned w) { return __uint_as_float(w & 0xffff0000u); }
DI void store8(bf16_t* p, f32x4 a, f32x4 b) { u32x4 w = {pk2(a[0], a[1]), pk2(a[2], a[3]), pk2(b[0], b[1]), pk2(b[2], b[3])}; *(u32x4*)p = w; }
DI void load8(const bf16_t* p, f32x4& a, f32x4& b) { const u32x4 w = *(const u32x4*)p; a = (f32x4){bflo(w.x), bfhi(w.x), bflo(w.y), bfhi(w.y)}; b = (f32x4){bflo(w.z), bfhi(w.z), bflo(w.w), bfhi(w.w)}; }
DI float fast_exp2(float x) { return __builtin_amdgcn_exp2f(x); }
DI float sigmoidf_(float x) { return __builtin_amdgcn_rcpf(1.0f + fast_exp2(-1.44269504f * x)); }
DI float wave_sum(float v) { v += __shfl_xor(v, 32); v += __shfl_xor(v, 16); v += __shfl_xor(v, 8); v += __shfl_xor(v, 4); v += __shfl_xor(v, 2); v += __shfl_xor(v, 1); return v; }

DI void rope4(f32x4& v, const float* tab, float sg, int xm) {
    f32x4 q;
#pragma unroll
    for (int i = 0; i < 4; ++i) q[i] = __shfl_xor(v[i], xm);
    const f32x4 t0 = *(const f32x4*)tab, t1 = *(const f32x4*)(tab + 4);
    v[0] = v[0] * t0[0] + sg * q[0] * t0[1]; v[1] = v[1] * t0[2] + sg * q[1] * t0[3];
    v[2] = v[2] * t1[0] + sg * q[2] * t1[1]; v[3] = v[3] * t1[2] + sg * q[3] * t1[3];
}
DI void rope8(f32x4& v0, f32x4& v1, const float* tab, bool first, int xm) {
    const float sg = first ? -1.f : 1.f;
    rope4(v0, tab, sg, xm); asm volatile("" ::: "memory");
    rope4(v1, tab + 8, sg, xm); asm volatile("" ::: "memory");
}

namespace pg8 {
constexpr int BM = 256, BK = 64, HALF = 128, HTB = HALF * BK * 2, STAGE_BYTES = 8 * HTB;
DI int lds_byte(int r, int c) { const int st = (r >> 4) * 2 + (c >> 5), rr = r & 15, cc = c & 31, ob = rr * 64 + cc * 2; return st * 1024 + (ob ^ (((ob >> 9) & 1) << 5)); }
DI void stage_rc(int b, int& R, int& C) { const int st = b / 1024, sb = b % 1024, swz = sb ^ (((sb >> 9) & 1) << 5); R = (st >> 1) * 16 + swz / 64; C = (st & 1) * 32 + (swz % 64) / 2; }
DI int perm32(int rho) { const int n = rho >> 4, i = rho & 15; return 8 * (i >> 2) + 4 * n + (i & 3); }

struct Unit { const char* a; const char* b; int pm, pn, s, z; };

struct Sub { const char* A; const char* B; int nM, nN, mmod; size_t tsa, tsb, zb; };
struct Sched {
    Sub s0, s1, s2; int ns, G, c, rep; size_t za, zb;
    DI bool pick(const Sub& S, int sid, long& L, int z, Unit& u) const {
        const long cnt = (long)S.nM * S.nN;
        if (L >= cnt) { L -= cnt; return false; }
        const int w = (int)L, nig = 8 * S.nN, gid = w / nig, fm = gid * 8, gsz = (S.nM - fm) < 8 ? (S.nM - fm) : 8;
        u.pm = fm + ((w % nig) % gsz); u.pn = (w % nig) / gsz; u.s = sid; u.z = z;
        u.a = S.A + (size_t)(u.pm % S.mmod) * S.tsa + (size_t)z * za;
        u.b = S.B + (size_t)u.pn * S.tsb + (size_t)(u.pm / S.mmod) * S.zb + (size_t)z * zb;
        return true;
    }
    DI bool next(int i, Unit& u) const {
        const int j = i / rep, z = i - j * rep;
        long L = (long)j * G + c;
        if (pick(s0, 0, L, z, u)) return true;
        if (ns > 1 && pick(s1, 1, L, z, u)) return true;
        if (ns > 2 && pick(s2, 2, L, z, u)) return true;
        return false;
    }
};
DI Sub mksub(const void* A, const void* B, int nM, int nN, int lda, int ldb) { Sub s; s.A = (const char*)A; s.B = (const char*)B; s.nM = nM; s.nN = nN; s.mmod = 1 << 30; s.tsa = (size_t)256 * lda * 2; s.tsb = (size_t)256 * ldb * 2; s.zb = 0; return s; }

template <class Epi>
DI void gemm_phase(LAS unsigned char* lds, const int K, const int lda, const int ldb, const Sched& S, const Epi& E) {
    int tid = threadIdx.x; asm volatile("" : "+v"(tid));
    const int wid = __builtin_amdgcn_readfirstlane(tid >> 6), lane = tid & 63, wr = wid >> 2, wc = wid & 3, fr = lane & 15, fq = lane >> 4;
    const int nt = K / BK;
    unsigned voffA[2], voffB[2];
#pragma unroll
    for (int i = 0; i < 2; ++i) { int R, C; stage_rc(tid * 16 + i * 8192, R, C); const int Rb = Epi::PERM ? ((R & ~31) + perm32(R & 31)) : R;
        voffA[i] = (unsigned)(R * lda + C) * 2u; voffB[i] = (unsigned)(Rb * ldb + C) * 2u; }
    const size_t kstep = (size_t)(BK * 2);
    const size_t hsA = (size_t)HALF * lda * 2, hsB = (size_t)HALF * ldb * 2;
    const unsigned ldsw = (unsigned)wid * 1024u;
    const int aoff = lds_byte(wr * 64 + fr, fq * 8), boff = lds_byte(wc * 32 + fr, fq * 8);
#define PG8_SA(b, h) (((b) * 2 + (h)) * HTB)
#define PG8_SB(b, h) ((4 + (b) * 2 + (h)) * HTB)
#define PG8_STAGE(bufoff, gbase, voff) do { _Pragma("unroll") for (int _i = 0; _i < 2; ++_i) \
        __builtin_amdgcn_global_load_lds((const unsigned*)((const char*)(gbase) + (voff)[_i]), (LAS unsigned*)(lds + (bufoff) + ldsw + _i * 8192), 16, 0, 0); } while (0)
#define PG8_LDA(dst, b, h) do { _Pragma("unroll") for (int m = 0; m < 4; ++m) _Pragma("unroll") for (int k = 0; k < 2; ++k) dst[m][k] = *(const LAS bf16x8*)(lds + PG8_SA(b, h) + aoff + m * 2048 + k * 1024); } while (0)
#define PG8_LDB(dst, b, h) do { _Pragma("unroll") for (int n = 0; n < 2; ++n) _Pragma("unroll") for (int k = 0; k < 2; ++k) dst[n][k] = *(const LAS bf16x8*)(lds + PG8_SB(b, h) + boff + n * 2048 + k * 1024); } while (0)
#define PG8_MMA(ai, bj, At, Bt) do { __builtin_amdgcn_s_setprio(1); _Pragma("unroll") for (int m = 0; m < 4; ++m) _Pragma("unroll") for (int n = 0; n < 2; ++n) _Pragma("unroll") for (int k = 0; k < 2; ++k) \
        acc[ai][bj][m][n] = __builtin_amdgcn_mfma_f32_16x16x32_bf16(Bt[n][k], At[m][k], acc[ai][bj][m][n], 0, 0, 0); __builtin_amdgcn_s_setprio(0); } while (0)
#define PG8_WAIT_V(n) asm volatile("s_waitcnt vmcnt(" #n ")" ::: "memory")
#define PG8_WAIT_L(n) asm volatile("s_waitcnt lgkmcnt(" #n ")" ::: "memory")
#define PG8_BAR __builtin_amdgcn_s_barrier()
#define PG8_SCHED __builtin_amdgcn_sched_barrier(0)
    Unit cur, nxt; int ui = 0;
    if (!S.next(0, cur)) return;
    f32x4 acc[2][2][4][2];
#pragma unroll
    for (int a = 0; a < 2; ++a)
#pragma unroll
        for (int b = 0; b < 2; ++b)
#pragma unroll
            for (int m = 0; m < 4; ++m)
#pragma unroll
                for (int n = 0; n < 2; ++n) acc[a][b][m][n] = (f32x4){0.f, 0.f, 0.f, 0.f};
    bf16x8 At[4][2], B0[2][2], B1[2][2];
    const char* cA = cur.a; const char* cB = cur.b;
    PG8_STAGE(PG8_SB(0, 0), cB, voffB); PG8_STAGE(PG8_SA(0, 0), cA, voffA); PG8_STAGE(PG8_SB(0, 1), cB + hsB, voffB); PG8_STAGE(PG8_SA(0, 1), cA + hsA, voffA);
    if (wr == 1) PG8_BAR;
    PG8_WAIT_V(4); PG8_BAR;
    PG8_STAGE(PG8_SB(1, 0), cB + kstep, voffB); PG8_STAGE(PG8_SA(1, 0), cA + kstep, voffA); PG8_STAGE(PG8_SB(1, 1), cB + hsB + kstep, voffB);
    PG8_WAIT_V(6); PG8_BAR;
    for (;;) {
        const bool has_next = S.next(ui + 1, nxt);
        const char* nA = has_next ? nxt.a : cA; const char* nB = has_next ? nxt.b : cB;
        for (int t = 0; t < nt; t += 2) {
            const bool last = (t == nt - 2);
            const char* a1 = cA + (size_t)(t + 1) * kstep;
            const char* a2 = last ? nA : cA + (size_t)(t + 2) * kstep; const char* b2 = last ? nB : cB + (size_t)(t + 2) * kstep;
            const char* a3 = a2 + kstep; const char* b3 = b2 + kstep;
            PG8_LDB(B0, 0, 0); PG8_SCHED; PG8_LDA(At, 0, 0); PG8_STAGE(PG8_SA(1, 1), a1 + hsA, voffA);
            PG8_WAIT_L(8); PG8_BAR; PG8_WAIT_L(0); PG8_MMA(0, 0, At, B0); PG8_BAR; PG8_SCHED;
            PG8_LDB(B1, 0, 1); PG8_STAGE(PG8_SB(0, 0), b2, voffB);
            PG8_BAR; PG8_WAIT_L(0); PG8_MMA(0, 1, At, B1); PG8_BAR;
            PG8_LDA(At, 0, 1); PG8_STAGE(PG8_SA(0, 0), a2, voffA);
            PG8_BAR; PG8_WAIT_L(0); PG8_MMA(1, 0, At, B0); PG8_BAR; PG8_SCHED;
            PG8_STAGE(PG8_SB(0, 1), b2 + hsB, voffB);
            PG8_WAIT_V(6); PG8_BAR; PG8_MMA(1, 1, At, B1); PG8_BAR;
            PG8_LDB(B0, 1, 0); PG8_SCHED; PG8_LDA(At, 1, 0); PG8_STAGE(PG8_SA(0, 1), a2 + hsA, voffA);
            PG8_WAIT_L(8); PG8_BAR; PG8_WAIT_L(0); PG8_MMA(0, 0, At, B0); PG8_BAR; PG8_SCHED;
            PG8_LDB(B1, 1, 1); PG8_STAGE(PG8_SB(1, 0), b3, voffB);
            PG8_BAR; PG8_WAIT_L(0); PG8_MMA(0, 1, At, B1); PG8_BAR;
            PG8_LDA(At, 1, 1); PG8_STAGE(PG8_SA(1, 0), a3, voffA);
            PG8_BAR; PG8_WAIT_L(0); PG8_MMA(1, 0, At, B0); PG8_BAR; PG8_SCHED;
            PG8_STAGE(PG8_SB(1, 1), b3 + hsB, voffB);
            PG8_WAIT_V(6); PG8_BAR; PG8_MMA(1, 1, At, B1); PG8_BAR;
        }
        { int fr2 = fr, fq2 = fq; asm volatile("" : "+v"(fr2), "+v"(fq2));
          E(acc, cur, wr, wc, fr2, fq2); }
        if (!has_next) break;
#pragma unroll
        for (int a = 0; a < 2; ++a)
#pragma unroll
            for (int b = 0; b < 2; ++b)
#pragma unroll
                for (int m = 0; m < 4; ++m)
#pragma unroll
                    for (int n = 0; n < 2; ++n) acc[a][b][m][n] = (f32x4){0.f, 0.f, 0.f, 0.f};
        cur = nxt; cA = nA; cB = nB; ++ui;
    }
    PG8_WAIT_V(0);
    if (wr == 0) PG8_BAR;
    PG8_BAR;
#undef PG8_SA
#undef PG8_SB
#undef PG8_STAGE
#undef PG8_LDA
#undef PG8_LDB
#undef PG8_MMA
#undef PG8_WAIT_V
#undef PG8_WAIT_L
#undef PG8_BAR
#undef PG8_SCHED
}
}
using pg8::Unit;
typedef const f32x4 (&AccRef)[2][2][4][2];

struct EpiSwiglu {
    static constexpr bool PERM = true;
    bf16_t* ACT;
    DI void operator()(AccRef acc, const Unit& u, int wr, int wc, int fr, int fq) const {
        const int row0 = u.pm * 256 + wr * 64 + fr, col0 = u.pn * 128 + wc * 32 + 8 * fq;
#pragma unroll
        for (int ai = 0; ai < 2; ++ai)
#pragma unroll
            for (int m = 0; m < 4; ++m) {
                f32x4 o[2];
#pragma unroll
                for (int n = 0; n < 2; ++n)
#pragma unroll
                    for (int i = 0; i < 4; ++i) { const float g = acc[ai][0][m][n][i]; o[n][i] = g * sigmoidf_(g) * acc[ai][1][m][n][i]; }
                store8(ACT + (size_t)(row0 + ai * 128 + m * 16) * DFF + col0, o[0], o[1]);
            }
    }
};
struct EpiResid {
    static constexpr bool PERM = false;
    float* H; const float* modl; int gidx; float fac;
    DI void operator()(AccRef acc, const Unit& u, int wr, int wc, int fr, int fq) const {
        const int mrow = (u.pm % 9 == 0) ? 8 : u.pm / 9;
        const float* gate = modl + (size_t)mrow * 9216 + gidx * 1024;
        const int row0 = u.pm * 256 + wr * 64 + fr, col0 = u.pn * 256 + wc * 32 + 4 * fq;
        f32x4 gv[2][2];
#pragma unroll
        for (int bj = 0; bj < 2; ++bj)
#pragma unroll
            for (int n = 0; n < 2; ++n) gv[bj][n] = *(const f32x4*)(gate + col0 + bj * 128 + n * 16) * fac;
#pragma unroll
        for (int ai = 0; ai < 2; ++ai)
#pragma unroll
            for (int m = 0; m < 4; ++m) {
                float* rowp = H + (size_t)(row0 + ai * 128 + m * 16) * DM + col0;
#pragma unroll
                for (int bj = 0; bj < 2; ++bj)
#pragma unroll
                    for (int n = 0; n < 2; ++n) { f32x4* p = (f32x4*)(rowp + bj * 128 + n * 16); *p = *p + gv[bj][n] * acc[ai][bj][m][n]; }
            }
    }
};
struct EpiIn {
    static constexpr bool PERM = true;
    bf16_t *QD, *KD, *PQ, *CKV, *G, *KM, *VTD, *FT, *FTC; float *rsq, *rskv; const float *RD, *RM;
    DI void operator()(AccRef acc, const Unit& u, int wr, int wc, int fr, int fq) const {
        if (u.s == 0) {
            const int pn = u.pn, tt = u.pm % 9; const bool lat = tt != 0;
            const int rl0 = wr * 64 + fr;
            if (pn < 4) {
                bf16_t* dst = (pn < 2) ? QD : KD;
                const int colb = (pn & 1) * 256 + wc * 32 + 8 * fq, sel = wc & 1; const bool first = (fq >> 1) == 0;
#pragma unroll
                for (int ai = 0; ai < 2; ++ai)
#pragma unroll
                    for (int m = 0; m < 4; ++m) {
                        const int rl = rl0 + ai * 128 + m * 16; const size_t row = (size_t)u.pm * 256 + rl; const int pos = (tt - 1) * 256 + rl;
#pragma unroll
                        for (int bj = 0; bj < 2; ++bj) {
                            f32x4 v0 = acc[ai][bj][m][0], v1 = acc[ai][bj][m][1];
                            if (lat) rope8(v0, v1, RD + ((size_t)pos * 32 + sel * 16 + 8 * (fq & 1)) * 2, first, 32);
                            store8(dst + row * 512 + colb + bj * 128, v0, v1);
                            asm volatile("" ::: "memory");
                        }
                    }
            } else if (pn < 6) {
#pragma unroll
                for (int ai = 0; ai < 2; ++ai)
#pragma unroll
                    for (int m = 0; m < 4; ++m) {
                        const int rl = rl0 + ai * 128 + m * 16; const size_t row = (size_t)u.pm * 256 + rl; const int pos = (tt - 1) * 256 + rl;
#pragma unroll
                        for (int bj = 0; bj < 2; ++bj) {
                            f32x4 v0 = acc[ai][bj][m][0], v1 = acc[ai][bj][m][1];
                            const int c = (pn - 4) * 256 + bj * 128 + wc * 32;
                            if (c < 384) {
                                float ss = v0[0] * v0[0] + v0[1] * v0[1] + v0[2] * v0[2] + v0[3] * v0[3] + v1[0] * v1[0] + v1[1] * v1[1] + v1[2] * v1[2] + v1[3] * v1[3];
                                ss += __shfl_xor(ss, 16); ss += __shfl_xor(ss, 32);
                                if (fq == 0) atomicAdd(rsq + row, ss);
                                store8(PQ + row * 512 + c + 8 * fq, v0, v1);
                            } else if (c == 384) {
                                if (lat) rope8(v0, v1, RM + ((size_t)pos * 16 + (fq >> 1) * 8) * 2, (fq & 1) == 0, 16);
#pragma unroll
                                for (int h = 0; h < 8; ++h) store8(KM + row * 768 + h * 96 + 64 + 8 * fq, v0, v1);
                            }
                            asm volatile("" ::: "memory");
                        }
                    }
            } else if (pn == 6) {
#pragma unroll
                for (int ai = 0; ai < 2; ++ai)
#pragma unroll
                    for (int m = 0; m < 4; ++m) {
                        const size_t row = (size_t)u.pm * 256 + rl0 + ai * 128 + m * 16;
#pragma unroll
                        for (int bj = 0; bj < 2; ++bj) {
                            const f32x4 v0 = acc[ai][bj][m][0], v1 = acc[ai][bj][m][1];
                            float ss = v0[0] * v0[0] + v0[1] * v0[1] + v0[2] * v0[2] + v0[3] * v0[3] + v1[0] * v1[0] + v1[1] * v1[1] + v1[2] * v1[2] + v1[3] * v1[3];
                            ss += __shfl_xor(ss, 16); ss += __shfl_xor(ss, 32);
                            if (fq == 0) atomicAdd(rskv + row, ss);
                            store8(CKV + row * 256 + bj * 128 + wc * 32 + 8 * fq, v0, v1);
                            asm volatile("" ::: "memory");
                        }
                    }
            } else {
                const int colb = (pn - 7) * 256 + wc * 32 + 8 * fq;
#pragma unroll
                for (int ai = 0; ai < 2; ++ai)
#pragma unroll
                    for (int m = 0; m < 4; ++m) {
                        const size_t row = (size_t)u.pm * 256 + rl0 + ai * 128 + m * 16;
#pragma unroll
                        for (int bj = 0; bj < 2; ++bj) {
                            f32x4 v0 = acc[ai][bj][m][0], v1 = acc[ai][bj][m][1];
#pragma unroll
                            for (int i = 0; i < 4; ++i) { v0[i] = sigmoidf_(v0[i]); v1[i] = sigmoidf_(v1[i]); }
                            store8(G + row * 3072 + colb + bj * 128, v0, v1);
                        }
                    }
            }
        } else {
            const int b = u.pn / 9, tt = u.pn % 9, cl = wc * 32 + 8 * fq;
#pragma unroll
            for (int ai = 0; ai < 2; ++ai)
#pragma unroll
                for (int m = 0; m < 4; ++m) {
                    const int r = u.pm * 256 + ai * 128 + wr * 64 + m * 16 + fr;
                    bf16_t* dst;
                    if (u.s == 1) dst = VTD + ((size_t)(b * 4 + (r >> 7)) * 128 + (r & 127)) * TPB + tt * 256;
                    else {
                        const int g = r >> 8, part = (r >> 7) & 1, mm = r & 127;
                        dst = (tt == 0) ? FTC + ((size_t)(b * 512 + g * 128 + mm) * 512 + part * 256)
                                        : FT + ((size_t)(b * 512 + g * 128 + mm) * 4096 + part * 2048 + (tt - 1) * 256);
                    }
#pragma unroll
                    for (int bj = 0; bj < 2; ++bj) store8(dst + bj * 128 + cl, acc[ai][bj][m][0], acc[ai][bj][m][1]);
                }
        }
    }
};
struct EpiUp {
    static constexpr bool PERM = true;
    bf16_t *QM, *KM, *VTM; const float *rsq, *rskv, *RM; int mode;
    DI void operator()(AccRef acc, const Unit& u, int wr, int wc, int fr, int fq) const {
        if (mode == 0) {
            const int tt = u.pm % 9; const bool lat = tt != 0; const int rl0 = wr * 64 + fr;
#pragma unroll
            for (int ai = 0; ai < 2; ++ai)
#pragma unroll
                for (int m = 0; m < 4; ++m) {
                    const int rl = rl0 + ai * 128 + m * 16; const size_t row = (size_t)u.pm * 256 + rl; const int pos = (tt - 1) * 256 + rl;
                    const float rs = __builtin_amdgcn_rsqf(rsq[row] * (1.0f / 384.0f) + RMS_EPS);
#pragma unroll
                    for (int bj = 0; bj < 2; ++bj) {
                        const int c = u.pn * 256 + bj * 128 + wc * 32;
                        f32x4 v0 = acc[ai][bj][m][0] * rs, v1 = acc[ai][bj][m][1] * rs;
                        if (((c >> 5) % 3) == 2 && lat) rope8(v0, v1, RM + ((size_t)pos * 16 + (fq >> 1) * 8) * 2, (fq & 1) == 0, 16);
                        store8(QM + row * 768 + c + 8 * fq, v0, v1);
                    }
                    asm volatile("" ::: "memory");
                }
        } else if (u.s == 0) {
#pragma unroll
            for (int ai = 0; ai < 2; ++ai)
#pragma unroll
                for (int m = 0; m < 4; ++m) {
                    const size_t row = (size_t)u.pm * 256 + wr * 64 + fr + ai * 128 + m * 16;
                    const float rs = __builtin_amdgcn_rsqf(rskv[row] * (1.0f / 256.0f) + RMS_EPS);
#pragma unroll
                    for (int bj = 0; bj < 2; ++bj) {
                        const int c = u.pn * 256 + bj * 128 + wc * 32 + 8 * fq;
                        store8(KM + row * 768 + (c >> 6) * 96 + (c & 63), acc[ai][bj][m][0] * rs, acc[ai][bj][m][1] * rs);
                    }
                    asm volatile("" ::: "memory");
                }
        } else {
            const int b = u.pn / 9, tt = u.pn % 9, cl = wc * 32 + 8 * fq;
#pragma unroll
            for (int bj = 0; bj < 2; ++bj) {
                f32x4 rs[2];
#pragma unroll
                for (int n = 0; n < 2; ++n) {
                    const f32x4 q = *(const f32x4*)(rskv + (size_t)u.pn * 256 + bj * 128 + cl + 4 * n);
#pragma unroll
                    for (int i = 0; i < 4; ++i) rs[n][i] = __builtin_amdgcn_rsqf(q[i] * (1.0f / 256.0f) + RMS_EPS);
                }
#pragma unroll
                for (int ai = 0; ai < 2; ++ai)
#pragma unroll
                    for (int m = 0; m < 4; ++m) {
                        const int r = u.pm * 256 + ai * 128 + wr * 64 + m * 16 + fr;
                        bf16_t* dst = VTM + ((size_t)(b * 8 + (r >> 6)) * 64 + (r & 63)) * TPB + tt * 256;
                        store8(dst + bj * 128 + cl, acc[ai][bj][m][0] * rs[0], acc[ai][bj][m][1] * rs[1]);
                    }
                asm volatile("" ::: "memory");
            }
        }
    }
};
struct EpiF2 {
    static constexpr bool PERM = true;
    bf16_t* Y; int ctx;
    DI void operator()(AccRef acc, const Unit& u, int wr, int wc, int fr, int fq) const {
        const size_t rowb = ctx ? (size_t)u.pm * TPB : (size_t)(u.pm >> 3) * TPB + 256 + (u.pm & 7) * 256;
#pragma unroll
        for (int ai = 0; ai < 2; ++ai)
#pragma unroll
            for (int m = 0; m < 4; ++m) {
                const size_t row = rowb + wr * 64 + fr + ai * 128 + m * 16;
#pragma unroll
                for (int bj = 0; bj < 2; ++bj) store8(Y + row * 1536 + 1024 + u.pn * 256 + bj * 128 + wc * 32 + 8 * fq, acc[ai][bj][m][0], acc[ai][bj][m][1]);
            }
    }
};
struct EpiMerge {
    static constexpr bool PERM = true;
    bf16_t* MG; const bf16_t* G;
    DI void operator()(AccRef acc, const Unit& u, int wr, int wc, int fr, int fq) const {
#pragma unroll
        for (int ai = 0; ai < 2; ++ai)
#pragma unroll
            for (int m = 0; m < 4; ++m) {
                const size_t row = (size_t)u.pm * 256 + wr * 64 + fr + ai * 128 + m * 16;
#pragma unroll
                for (int bj = 0; bj < 2; ++bj) {
                    const int c = u.pn * 256 + bj * 128 + wc * 32 + 8 * fq;
                    f32x4 g0, g1; load8(G + row * 3072 + u.z * 1024 + c, g0, g1);
                    f32x4 v0 = g0 * acc[ai][bj][m][0], v1 = g1 * acc[ai][bj][m][1];
                    if (u.z > 0) { f32x4 p0, p1; load8(MG + row * 1024 + c, p0, p1); v0 += p0; v1 += p1; }
                    store8(MG + row * 1024 + c, v0, v1);
                }
            }
    }
};

#define MFMA32(a, b, c) __builtin_amdgcn_mfma_f32_32x32x16_bf16((a), (b), (c), 0, 0, 0)
template <int D, int DV, bool DIFF>
DI void attn_item(LAS unsigned char* lds, const bf16_t* Qb, int ldq, const bf16_t* Kb, int ldk, const bf16_t* VT, int nkeys, int nq,
                  bf16_t* Yb, float lam, float outfac, const float* subg) {
    constexpr int KROW = (DIFF ? 256 : 192) + 16, VROW = 144, KBYTES = 64 * KROW, VBYTES = DV * VROW, STAGE = KBYTES + VBYTES;
    constexpr int KCH = DIFF ? 16 : 12, NKC = 64 * KCH, NVC = DV * 8, NKK = D / 16, NDVB = DV / 32;
    int tid = threadIdx.x; asm volatile("" : "+v"(tid));
    const int wave = __builtin_amdgcn_readfirstlane(tid >> 6), lane = tid & 63, l32 = lane & 31, half = lane >> 5;
    const float cs = (DIFF ? 0.125f : 0.10206207261596575f) * 1.4426950408889634f;
    const bool active = DIFF ? true : (wave * 64 < nq);
    bf16x8 qf[2][DIFF ? 1 : NKK];
    const LAS unsigned char* qlds = lds + 2 * STAGE + (wave * 32 + l32) * KROW + half * 16;
    if (DIFF) {
#pragma unroll
        for (int i = 0; i < 8; ++i) { const int ch = tid + i * NT, r = ch >> 4, cc = ch & 15;
            *(LAS u32x4*)(lds + 2 * STAGE + r * KROW + cc * 16) = *(const u32x4*)(Qb + (size_t)r * ldq + cc * 8); }
    } else {
#pragma unroll
        for (int s = 0; s < 2; ++s)
#pragma unroll
            for (int kk = 0; kk < NKK; ++kk) {
                const int qr = wave * 64 + s * 32 + l32, qc = kk * 16 + half * 8;
                qf[s][DIFF ? 0 : kk] = active ? *(const bf16x8*)(Qb + (size_t)qr * ldq + qc) : (bf16x8){0, 0, 0, 0, 0, 0, 0, 0};
            }
    }
    f32x16 O[2][NDVB];
#pragma unroll
    for (int s = 0; s < 2; ++s)
#pragma unroll
        for (int d = 0; d < NDVB; ++d)
#pragma unroll
            for (int i = 0; i < 16; ++i) O[s][d][i] = 0.f;
    float mrun[2] = {-1e30f, -1e30f}, lsum[2] = {0.f, 0.f};
    const int nt = nkeys / 64;
    u32x4 kr[2], vr[2];
    const int kc0 = tid, kc1 = tid + NT;
    const bool k1ok = kc1 < NKC, v1ok = (tid + NT) < NVC;
    const int krow0 = kc0 / KCH, kcc0 = kc0 % KCH, krow1 = kc1 / KCH, kcc1 = kc1 % KCH;
    const int vrow0 = tid >> 3, vcc0 = tid & 7, vrow1 = (tid + NT) >> 3;
#define ATT_LOAD(t) do { const int key0 = (t) * 64; \
        kr[0] = *(const u32x4*)(Kb + (size_t)(key0 + krow0) * ldk + kcc0 * 8); \
        if (k1ok) kr[1] = *(const u32x4*)(Kb + (size_t)(key0 + krow1) * ldk + kcc1 * 8); \
        vr[0] = *(const u32x4*)(VT + (size_t)vrow0 * TPB + key0 + vcc0 * 8); \
        if (v1ok) vr[1] = *(const u32x4*)(VT + (size_t)vrow1 * TPB + key0 + vcc0 * 8); } while (0)
#define ATT_WRITE(st) do { LAS unsigned char* sb = lds + (st) * STAGE; \
        *(LAS u32x4*)(sb + krow0 * KROW + kcc0 * 16) = kr[0]; \
        if (k1ok) *(LAS u32x4*)(sb + krow1 * KROW + kcc1 * 16) = kr[1]; \
        *(LAS u32x4*)(sb + KBYTES + vrow0 * VROW + vcc0 * 16) = vr[0]; \
        if (v1ok) *(LAS u32x4*)(sb + KBYTES + vrow1 * VROW + vcc0 * 16) = vr[1]; } while (0)
    ATT_LOAD(0); ATT_WRITE(0); __syncthreads();
    for (int t = 0; t < nt; ++t) {
        if (t + 1 < nt) ATT_LOAD(t + 1);
        if (active) {
            const LAS unsigned char* sb = lds + (t & 1) * STAGE;
#pragma unroll
            for (int kb = 0; kb < 2; ++kb) {
                bf16x8 P[2][2];
                f32x16 S[2];
                if (!DIFF) {
#pragma unroll
                    for (int s = 0; s < 2; ++s)
#pragma unroll
                        for (int i = 0; i < 16; ++i) S[s][i] = 0.f;
#pragma unroll
                    for (int kk = 0; kk < NKK; ++kk) {
                        const bf16x8 kf = *(const LAS bf16x8*)(sb + (kb * 32 + l32) * KROW + (kk * 16 + half * 8) * 2);
                        S[0] = MFMA32(kf, qf[0][DIFF ? 0 : kk], S[0]); S[1] = MFMA32(kf, qf[1][DIFF ? 0 : kk], S[1]);
                    }
                }
#pragma unroll
                for (int s = 0; s < 2; ++s) {
                    if (DIFF) {
#pragma unroll
                        for (int i = 0; i < 16; ++i) S[s][i] = 0.f;
#pragma unroll
                        for (int kk = 0; kk < NKK; ++kk) {
                            const bf16x8 kf = *(const LAS bf16x8*)(sb + (kb * 32 + l32) * KROW + (s * 64 + kk * 16 + half * 8) * 2);
                            const bf16x8 qq = *(const LAS bf16x8*)(qlds + (s * 64 + kk * 16) * 2);
                            S[s] = MFMA32(kf, qq, S[s]);
                        }
                    }
                    float mx = S[s][0];
#pragma unroll
                    for (int i = 1; i < 16; ++i) mx = fmaxf(mx, S[s][i]);
                    mx = fmaxf(mx, __shfl_xor(mx, 32));
                    const float mt2 = mx * cs;
                    if (__builtin_amdgcn_ballot_w64(mt2 > mrun[s] + 8.0f) != 0ull) {
                        const float mnew = fmaxf(mrun[s], mt2), alpha = fast_exp2(mrun[s] - mnew);
                        lsum[s] *= alpha;
#pragma unroll
                        for (int d = 0; d < NDVB; ++d)
#pragma unroll
                            for (int i = 0; i < 16; ++i) O[s][d][i] *= alpha;
                        mrun[s] = mnew;
                    }
                    float ls = 0.f;
#pragma unroll
                    for (int i = 0; i < 16; ++i) { S[s][i] = fast_exp2(S[s][i] * cs - mrun[s]); ls += S[s][i]; }
                    lsum[s] += ls;
#pragma unroll
                    for (int k2 = 0; k2 < 2; ++k2) {
                        u32x4 w = {pk2(S[s][8 * k2], S[s][8 * k2 + 1]), pk2(S[s][8 * k2 + 2], S[s][8 * k2 + 3]), pk2(S[s][8 * k2 + 4], S[s][8 * k2 + 5]), pk2(S[s][8 * k2 + 6], S[s][8 * k2 + 7])};
                        P[s][k2] = __builtin_bit_cast(bf16x8, w);
                    }
                    if (DIFF) asm volatile("" ::: "memory");
                }
#pragma unroll
                for (int d = 0; d < NDVB; ++d)
#pragma unroll
                    for (int k2 = 0; k2 < 2; ++k2) {
                        const LAS unsigned char* va = sb + KBYTES + (d * 32 + l32) * VROW + (kb * 32 + k2 * 16 + half * 4) * 2;
                        const u32x2 lo = *(const LAS u32x2*)va, hi = *(const LAS u32x2*)(va + 16);
                        const u32x4 w = {lo.x, lo.y, hi.x, hi.y};
                        const bf16x8 vf = __builtin_bit_cast(bf16x8, w);
                        O[0][d] = MFMA32(vf, P[0][k2], O[0][d]); O[1][d] = MFMA32(vf, P[1][k2], O[1][d]);
                        if (DIFF) asm volatile("" ::: "memory");
                    }
            }
        }
        if (t + 1 < nt) ATT_WRITE((t + 1) & 1);
        __syncthreads();
    }
#undef ATT_LOAD
#undef ATT_WRITE
    if (!active) return;
    int l32e = l32, halfe = half; asm volatile("" : "+v"(l32e), "+v"(halfe));
    float inv[2];
#pragma unroll
    for (int s = 0; s < 2; ++s) { const float l = lsum[s] + __shfl_xor(lsum[s], 32); inv[s] = 1.0f / l; }
    if (DIFF) {
        float ss = 0.f;
#pragma unroll
        for (int d = 0; d < NDVB; ++d)
#pragma unroll
            for (int i = 0; i < 16; ++i) { const float o = O[0][d][i] * inv[0] - lam * (O[1][d][i] * inv[1]); O[0][d][i] = o; ss += o * o; }
        ss += __shfl_xor(ss, 32);
        const float rs = __builtin_amdgcn_rsqf(ss * (1.0f / 128.0f) + RMS_EPS) * outfac;
        bf16_t* yr = Yb + (size_t)(wave * 32 + l32e) * 1536;
#pragma unroll
        for (int d = 0; d < NDVB; ++d)
#pragma unroll
            for (int g4 = 0; g4 < 4; ++g4) {
                const int dv = d * 32 + g4 * 8 + halfe * 4;
                const f32x4 gg = *(const f32x4*)(subg + dv);
                u32x2 w = {pk2(O[0][d][4 * g4] * rs * gg[0], O[0][d][4 * g4 + 1] * rs * gg[1]), pk2(O[0][d][4 * g4 + 2] * rs * gg[2], O[0][d][4 * g4 + 3] * rs * gg[3])};
                *(u32x2*)(yr + dv) = w;
            }
    } else {
#pragma unroll
        for (int s = 0; s < 2; ++s) {
            bf16_t* yr = Yb + (size_t)(wave * 64 + s * 32 + l32e) * 1536;
#pragma unroll
            for (int d = 0; d < NDVB; ++d)
#pragma unroll
                for (int g4 = 0; g4 < 4; ++g4) {
                    const int dv = d * 32 + g4 * 8 + halfe * 4;
                    u32x2 w = {pk2(O[s][d][4 * g4] * inv[s], O[s][d][4 * g4 + 1] * inv[s]), pk2(O[s][d][4 * g4 + 2] * inv[s], O[s][d][4 * g4 + 3] * inv[s])};
                    *(u32x2*)(yr + dv) = w;
                }
        }
    }
}

DI int mapcol(int kind, int n) {
    switch (kind) {
        case 1: { const int pn = n >> 8, r = n & 255; return r < 128 ? pn * 128 + r : DFF + pn * 128 + (r - 128); }
        case 2: return n < 1024 ? n : n < 1408 ? 1536 + (n - 1024) : n < 1440 ? 2176 + (n - 1408) : n < 1536 ? -1 : n < 1792 ? 1920 + (n - 1536) : 2720 + (n - 1792);
        case 3: return 1024 + n;
        case 4: return (n >> 6) * 128 + (n & 63);
        case 5: return (n >> 6) * 128 + 64 + (n & 63);
        default: return n;
    }
}
DI void prepT(LAS float* tile, bf16_t* dst, const float* src, int lds_, int Kd, int Nd, int kind, const float* kscale, int& rot) {
    int tid = threadIdx.x; asm volatile("" : "+v"(tid));
    const int G = gridDim.x, ntk = Kd >> 6, ntiles = ntk * (Nd >> 6);
    for (int t = (int)((blockIdx.x + (unsigned)G - (unsigned)(rot % G)) % (unsigned)G); t < ntiles; t += G) {
        const int k0 = (t % ntk) << 6, n0 = (t / ntk) << 6;
        const int nn = tid & 63, sc = mapcol(kind, n0 + nn);
#pragma unroll
        for (int ps = 0; ps < 8; ++ps) {
            const int kk = ps * 8 + (tid >> 6);
            float v = sc >= 0 ? src[(size_t)(k0 + kk) * lds_ + sc] : 0.f;
            if (kscale) v *= kscale[k0 + kk];
            tile[kk * 65 + nn] = v;
        }
        __syncthreads();
        const int on = tid >> 3, kc = tid & 7;
        u32x4 w;
        w.x = pk2(tile[(kc * 8 + 0) * 65 + on], tile[(kc * 8 + 1) * 65 + on]); w.y = pk2(tile[(kc * 8 + 2) * 65 + on], tile[(kc * 8 + 3) * 65 + on]);
        w.z = pk2(tile[(kc * 8 + 4) * 65 + on], tile[(kc * 8 + 5) * 65 + on]); w.w = pk2(tile[(kc * 8 + 6) * 65 + on], tile[(kc * 8 + 7) * 65 + on]);
        *(u32x4*)(dst + (size_t)(n0 + on) * Kd + k0 + kc * 8) = w;
        __syncthreads();
    }
    rot += ntiles;
}

DI void prologue(const Params& p, LAS unsigned char* lds) {
    int tid = threadIdx.x; asm volatile("" : "+v"(tid));
    const int G = gridDim.x, bid = blockIdx.x;
    const size_t gtid = (size_t)bid * NT + tid, gsz = (size_t)G * NT;
    unsigned char* ws = p.ws;
    {
        f32x4* H = (f32x4*)(ws + OFF_H);
        for (size_t i = gtid; i < (size_t)T * 256; i += gsz) {
            const int t = (int)(i >> 8), c4 = (int)(i & 255), b = t / TPB, r = t - b * TPB;
            H[i] = r < CTX ? ((const f32x4*)p.ctx)[((size_t)b * CTX + r) * 256 + c4] : ((const f32x4*)p.x)[((size_t)b * SEQ + (r - CTX)) * 256 + c4];
        }
    }
    {
        float* RD = (float*)(ws + OFF_ROPED); float* RM = (float*)(ws + OFF_ROPEM);
        for (size_t i = gtid; i < (size_t)2048 * 32; i += gsz) {
            const int pos = (int)(i >> 5), e = (int)(i & 31), sel = e >> 4, j = e & 15;
            const float fr = __powf(10000.f, -(float)j / 16.f), ang = (float)(sel ? (pos & 63) : (pos >> 6)) * fr, rev = ang * 0.15915494309189535f;
            RD[2 * i] = __builtin_amdgcn_cosf(rev); RD[2 * i + 1] = __builtin_amdgcn_sinf(rev);
        }
        for (size_t i = gtid; i < (size_t)2048 * 16; i += gsz) {
            const int pos = (int)(i >> 4), e = (int)(i & 15), sel = e >> 3, j = e & 7;
            const float fr = __powf(10000.f, -(float)j / 8.f), ang = (float)(sel ? (pos & 63) : (pos >> 6)) * fr, rev = ang * 0.15915494309189535f;
            RM[2 * i] = __builtin_amdgcn_cosf(rev); RM[2 * i + 1] = __builtin_amdgcn_sinf(rev);
        }
    }
    {
        u32x4* DL = (u32x4*)(ws + OFF_DFTL);
        for (size_t i = gtid; i < (size_t)2048 * 512; i += gsz) {
            const int k = (int)(i >> 9), c8 = (int)(i & 511) * 8, part = c8 >> 11, n0 = c8 & 2047;
            float v[8];
#pragma unroll
            for (int j = 0; j < 8; ++j) { const float fr = (float)((k * (n0 + j)) & 2047) * (1.0f / 2048.0f);
                v[j] = (part ? -__builtin_amdgcn_sinf(fr) : __builtin_amdgcn_cosf(fr)) * 0.022097086912079608f; }
            DL[i] = (u32x4){pk2(v[0], v[1]), pk2(v[2], v[3]), pk2(v[4], v[5]), pk2(v[6], v[7])};
        }
        u32x4* DC = (u32x4*)(ws + OFF_DFTC);
        for (size_t i = gtid; i < (size_t)256 * 64; i += gsz) {
            const int k = (int)(i >> 6), c8 = (int)(i & 63) * 8, part = c8 >> 8, n0 = c8 & 255;
            float v[8];
#pragma unroll
            for (int j = 0; j < 8; ++j) { const float fr = (float)((k * (n0 + j)) & 255) * (1.0f / 256.0f);
                v[j] = (part ? -__builtin_amdgcn_sinf(fr) : __builtin_amdgcn_cosf(fr)) * 0.0625f; }
            DC[i] = (u32x4){pk2(v[0], v[1]), pk2(v[2], v[3]), pk2(v[4], v[5]), pk2(v[6], v[7])};
        }
    }
    if (bid == 0 && tid < DEPTH) {
        const float* dl = p.diff_lambda + tid * 4 * 64; float a = 0.f, b = 0.f;
        for (int i = 0; i < 64; ++i) { a += dl[i] * dl[64 + i]; b += dl[128 + i] * dl[192 + i]; }
        const float lam_init = 0.8f - 0.6f * expf(-0.3f * (float)tid);
        ((float*)(ws + OFF_LAM))[tid] = expf(a) - expf(b) + lam_init;
        ((float*)(ws + OFF_LAM))[4 + tid] = 1.0f - lam_init;
    }
    {
        LAS float* sc = (LAS float*)lds;
        LAS float* red = (LAS float*)(lds + 40960);
        for (int i = tid; i < 9 * 1024; i += NT) { const float v = i < 8192 ? p.c[i] : p.c_ctx[i - 8192]; sc[i] = v * sigmoidf_(v); }
        __syncthreads();
        float* MOD = (float*)(ws + OFF_MOD);
        for (int it = bid; it < DEPTH * 144; it += G) {
            const int l = it / 144, n0 = (it % 144) * 64, col = tid & 63, kg = tid >> 6;
            const float* w = p.ada_w + (size_t)l * 1024 * 9216 + n0 + col;
            float a[9];
#pragma unroll
            for (int r = 0; r < 9; ++r) a[r] = 0.f;
            for (int k = kg * 128; k < kg * 128 + 128; ++k) {
                const float wv = w[(size_t)k * 9216];
#pragma unroll
                for (int r = 0; r < 9; ++r) a[r] += sc[r * 1024 + k] * wv;
            }
#pragma unroll
            for (int r = 0; r < 9; ++r) red[(kg * 9 + r) * 64 + col] = a[r];
            __syncthreads();
            for (int o = tid; o < 576; o += NT) {
                const int r = o >> 6, cc = o & 63; float s = p.ada_b[l * 9216 + n0 + cc];
#pragma unroll
                for (int g = 0; g < 8; ++g) s += red[(g * 9 + r) * 64 + cc];
                MOD[((size_t)l * 9 + r) * 9216 + n0 + cc] = s;
            }
            __syncthreads();
        }
    }
    {
        LAS float* wt = (LAS float*)lds;
        LAS float* tc = (LAS float*)(lds + 16384);
        LAS bf16_t* ot = (LAS bf16_t*)(lds + 20480);
        for (int i = tid; i < 128; i += NT) { tc[i] = __builtin_amdgcn_cosf((float)i * (1.0f / 128.0f)); tc[128 + i] = __builtin_amdgcn_sinf((float)i * (1.0f / 128.0f)); }
        for (int it = bid; it < DEPTH * 4 * 32; it += G) {
            const int l = it >> 7, g = (it >> 5) & 3, k0 = (it & 31) * 32;
            __syncthreads();
            for (int i = tid; i < 32 * 128; i += NT) wt[i] = p.w_in[((size_t)l * 1024 + k0 + (i >> 7)) * INW + 2208 + g * 128 + (i & 127)];
            __syncthreads();
            const int pmi = tid & 255, part = pmi >> 7, m = pmi & 127, kh = tid >> 8;
            float a[16];
#pragma unroll
            for (int i = 0; i < 16; ++i) a[i] = 0.f;
            for (int c = 0; c < 128; ++c) {
                const float tv = tc[part * 128 + ((m * c) & 127)];
#pragma unroll
                for (int i = 0; i < 16; ++i) a[i] += wt[(2 * i + kh) * 128 + c] * tv;
            }
#pragma unroll
            for (int i = 0; i < 16; ++i) { const unsigned w = pk2(a[i] * 0.08838834764831845f, 0.f); ot[pmi * 32 + 2 * i + kh] = (bf16_t)(w & 0xffffu); }
            __syncthreads();
            bf16_t* AF = (bf16_t*)(ws + OFF_W) + (size_t)l * WE_END + WE_F;
            for (int ch = tid; ch < 1024; ch += NT) {
                const int r = ch >> 2, q = ch & 3;
                *(u32x4*)(AF + (size_t)(g * 256 + r) * 1024 + k0 + q * 8) = *(const LAS u32x4*)(ot + r * 32 + q * 8);
            }
        }
        __syncthreads();
    }
    {
        LAS float* tile = (LAS float*)lds; int rot = 0;
        for (int l = 0; l < DEPTH; ++l) {
            bf16_t* W = (bf16_t*)(ws + OFF_W) + (size_t)l * WE_END;
            for (int s = 0; s < 2; ++s) {
                prepT(tile, W + WE_W1 + (size_t)s * 5632 * 1024, p.ffn_w_in + ((size_t)l * 2 + s) * 1024 * 5632, 5632, 1024, 5632, 1, nullptr, rot);
                prepT(tile, W + WE_W2 + (size_t)s * 1024 * 2816, p.ffn_w_out + ((size_t)l * 2 + s) * 2816 * 1024, 1024, 2816, 1024, 0, nullptr, rot);
            }
            const float* win = p.w_in + (size_t)l * 1024 * INW;
            prepT(tile, W + WE_IN, win, INW, 1024, 4864, 2, nullptr, rot);
            prepT(tile, W + WE_V, win, INW, 1024, 512, 3, nullptr, rot);
            prepT(tile, W + WE_UQ, p.mla_w_uq + (size_t)l * 384 * 768, 768, 384, 768, 0, p.mla_q_norm_g + l * 384, rot);
            prepT(tile, W + WE_UK, p.mla_w_ukv + (size_t)l * 256 * 1024, 1024, 256, 512, 4, p.mla_kv_norm_g + l * 256, rot);
            prepT(tile, W + WE_UV, p.mla_w_ukv + (size_t)l * 256 * 1024, 1024, 256, 512, 5, p.mla_kv_norm_g + l * 256, rot);
            prepT(tile, W + WE_B, p.w_bd + (size_t)l * 512 * 1024, 1024, 512, 1024, 0, nullptr, rot);
            prepT(tile, W + WE_B + (size_t)1024 * 512, p.w_bm + (size_t)l * 512 * 1024, 1024, 512, 1024, 0, nullptr, rot);
            prepT(tile, W + WE_B + (size_t)2 * 1024 * 512, p.w_bf + (size_t)l * 512 * 1024, 1024, 512, 1024, 0, nullptr, rot);
            prepT(tile, W + WE_O, p.w_out + (size_t)l * 1024 * 1024, 1024, 1024, 1024, 0, nullptr, rot);
        }
    }
}

DI void norm_phase(const Params& p, const float* gain, const float* modl, int sh_i, int sc_i, bool zero) {
    int tid = threadIdx.x; asm volatile("" : "+v"(tid));
    const int lane = tid & 63, gw = blockIdx.x * 8 + (tid >> 6), nw = gridDim.x * 8;
    const float* H = (const float*)(p.ws + OFF_H); bf16_t* AN = (bf16_t*)(p.ws + OFF_AN);
    f32x4 g[4];
#pragma unroll
    for (int j = 0; j < 4; ++j) g[j] = *(const f32x4*)(gain + (lane + 64 * j) * 4);
    for (int t0 = gw; t0 < T; t0 += nw * 4) {
        f32x4 v[4][4]; float ss[4];
#pragma unroll
        for (int r = 0; r < 4; ++r) {
            const int t = t0 + r * nw; const bool ok = t < T;
            const f32x4* hr = (const f32x4*)(H + (size_t)(ok ? t : t0) * DM);
#pragma unroll
            for (int j = 0; j < 4; ++j) v[r][j] = hr[lane + 64 * j];
        }
#pragma unroll
        for (int r = 0; r < 4; ++r) {
            float s = 0.f;
#pragma unroll
            for (int j = 0; j < 4; ++j) s += v[r][j][0] * v[r][j][0] + v[r][j][1] * v[r][j][1] + v[r][j][2] * v[r][j][2] + v[r][j][3] * v[r][j][3];
            ss[r] = wave_sum(s);
        }
#pragma unroll
        for (int r = 0; r < 4; ++r) {
            const int t = t0 + r * nw;
            if (t < T) {
                const float rs = __builtin_amdgcn_rsqf(ss[r] * (1.0f / 1024.0f) + RMS_EPS);
                const int b = t / TPB, rr = t - b * TPB, mrow = rr < CTX ? 8 : b;
                const float* sh = modl + (size_t)mrow * 9216 + sh_i * 1024; const float* sc = modl + (size_t)mrow * 9216 + sc_i * 1024;
#pragma unroll
                for (int j = 0; j < 4; ++j) {
                    const int c = (lane + 64 * j) * 4;
                    const f32x4 s1 = *(const f32x4*)(sc + c), s0 = *(const f32x4*)(sh + c);
                    const f32x4 y = (v[r][j] * rs * g[j]) * (s1 + 1.0f) + s0;
                    *(u32x2*)(AN + (size_t)t * DM + c) = (u32x2){pk2(y[0], y[1]), pk2(y[2], y[3])};
                }
            }
        }
    }
    if (zero) {
        float* a = (float*)(p.ws + OFF_RSQ);
        for (size_t i = (size_t)blockIdx.x * NT + tid; i < (size_t)2 * T; i += (size_t)gridDim.x * NT) a[i] = 0.f;
    }
}
DI void final_phase(const Params& p) {
    int tid = threadIdx.x; asm volatile("" : "+v"(tid));
    const int lane = tid & 63, gw = blockIdx.x * 8 + (tid >> 6), nw = gridDim.x * 8;
    const float* H = (const float*)(p.ws + OFF_H);
    for (int q = gw; q < NB * SEQ; q += nw) {
        const int b = q >> 11, n = q & 2047;
        const f32x4* hr = (const f32x4*)(H + ((size_t)b * TPB + CTX + n) * DM);
        f32x4 v[4]; float ss = 0.f;
#pragma unroll
        for (int j = 0; j < 4; ++j) { v[j] = hr[lane + 64 * j]; ss += v[j][0] * v[j][0] + v[j][1] * v[j][1] + v[j][2] * v[j][2] + v[j][3] * v[j][3]; }
        ss = wave_sum(ss);
        const float rs = __builtin_amdgcn_rsqf(ss * (1.0f / 1024.0f) + RMS_EPS);
#pragma unroll
        for (int j = 0; j < 4; ++j) { const int c = (lane + 64 * j) * 4; *(f32x4*)(p.out + (size_t)q * DM + c) = v[j] * rs * *(const f32x4*)(p.final_g + c); }
    }
}

#define XB_TMO      128
#define XB_XCNT(j)  (256  + 64 * (j))
#define XB_XSUB(j)  (1280 + 64 * (j))
#define XB_XGEN(j)  (2304 + 64 * (j))
#define XB_TOP      3328
#define XB_TOPGEN   3392
#define XB_SPIN_CAP (1u << 22)
DI unsigned xb_ld(unsigned* p) { return __hip_atomic_load(p, __ATOMIC_RELAXED, __HIP_MEMORY_SCOPE_AGENT); }
DI unsigned xb_add(unsigned* p, unsigned v) { return __hip_atomic_fetch_add(p, v, __ATOMIC_RELAXED, __HIP_MEMORY_SCOPE_AGENT); }
DI unsigned xb_xcc_id() { return (unsigned)__builtin_amdgcn_s_getreg((3 << 11) | 20) & 0xFu; }
#define XB_SPIN(cond, bar) do { unsigned _sp = 0; while (cond) { __builtin_amdgcn_s_sleep(1); \
    if ((++_sp & 255u) == 0u) { if (xb_ld(&(bar)[XB_TMO])) break; if (_sp > XB_SPIN_CAP) { atomicAdd(&(bar)[XB_TMO], 1u); break; } } } } while (0)
struct XcdBarrier { unsigned* bar; unsigned x; volatile LAS unsigned* st; };
DI XcdBarrier xcd_barrier_post(unsigned* bar, volatile LAS unsigned* st) {
    XcdBarrier b; b.bar = bar; b.x = xb_xcc_id(); b.st = st;
    if (threadIdx.x == 0) (void)xb_add(&bar[XB_XCNT(b.x)], 1u);
    return b;
}
DI void xcd_barrier_complete(unsigned* bar, unsigned x, unsigned& nloc, unsigned& nx) {
    const unsigned G = gridDim.x * gridDim.y * gridDim.z;
    unsigned sum, cnt, mine, sp = 0u;
    for (;;) {
        sum = 0u; cnt = 0u; mine = 0u;
#pragma unroll
        for (unsigned j = 0; j < 16; ++j) { const unsigned c = xb_ld(&bar[XB_XCNT(j)]); sum += c; cnt += (c > 0u) ? 1u : 0u; mine = (j == x) ? c : mine; }
        if (sum == G) break;
        __builtin_amdgcn_s_sleep(1);
        if ((++sp & 255u) == 0u) { if (xb_ld(&bar[XB_TMO])) break; if (sp > XB_SPIN_CAP) { atomicAdd(&bar[XB_TMO], 1u); break; } }
    }
    nloc = mine > 0u ? mine : 1u; nx = cnt > 0u ? cnt : 1u;
}
DI void xcd_barrier(const XcdBarrier& b) {
    asm volatile("s_waitcnt vmcnt(0)" ::: "memory");
    __syncthreads();
    if (threadIdx.x == 0) {
        unsigned* bar = b.bar;
        __builtin_amdgcn_s_waitcnt(0);
        unsigned nloc = b.st[0], nx = b.st[1];
        if (nloc == 0u) { xcd_barrier_complete(bar, b.x, nloc, nx); b.st[0] = nloc; b.st[1] = nx; }
        const unsigned old = xb_add(&bar[XB_XSUB(b.x)], 1u);
        const unsigned gen = old / nloc;
        if (old + 1u == (gen + 1u) * nloc) {
            __builtin_amdgcn_fence(__ATOMIC_RELEASE, "agent");
            asm volatile("s_waitcnt vmcnt(0)" ::: "memory");
            const unsigned og = xb_add(&bar[XB_TOP], 1u);
            const unsigned tg = og / nx;
            if (og + 1u == (tg + 1u) * nx) xb_add(&bar[XB_TOPGEN], 1u);
            else XB_SPIN(xb_ld(&bar[XB_TOPGEN]) == tg, bar);
            __builtin_amdgcn_fence(__ATOMIC_ACQUIRE, "agent");
            xb_add(&bar[XB_XGEN(b.x)], 1u);
            asm volatile("s_waitcnt vmcnt(0)" ::: "memory");
        } else {
            XB_SPIN(xb_ld(&bar[XB_XGEN(b.x)]) == gen, bar);
            __builtin_amdgcn_fence(__ATOMIC_ACQUIRE, "agent");
            asm volatile("s_waitcnt vmcnt(0)" ::: "memory");
        }
    }
    __syncthreads();
}

constexpr int NPH = 2 + 12 * DEPTH;
#ifndef PH_MASK
#define PH_MASK 0xffff
#endif
#define EN(k) (((PH_MASK) >> (k)) & 1)
#ifndef ATT_MASK
#define ATT_MASK 0xf
#endif
#define AEN(k) (((ATT_MASK) >> (k)) & 1)
__global__ void __launch_bounds__(NT, 2) fwd_kernel(Params p) {
    extern __shared__ __attribute__((aligned(16))) unsigned char shm[];
    LAS unsigned char* lds = (LAS unsigned char*)shm;
    const int G = gridDim.x, bid = blockIdx.x;
    if (threadIdx.x < 4) ((LAS unsigned*)(lds + LDS_MAIN))[threadIdx.x] = 0u;
    __syncthreads();
    XcdBarrier xbar = xcd_barrier_post((unsigned*)(p.ws + OFF_BAR), (volatile LAS unsigned*)(lds + LDS_MAIN));
    for (int ph = p.ph_lo; ph < p.ph_hi; ++ph) {
      for (int rep_ = 0; rep_ < REPS(ph); ++rep_) {
        unsigned char* ws = p.ws; asm volatile("" : "+s"(ws));
        float* H = (float*)(ws + OFF_H); bf16_t* AN = (bf16_t*)(ws + OFF_AN); bf16_t* MG = AN;
        bf16_t* ACT = (bf16_t*)(ws + OFF_R1); bf16_t* GT = (bf16_t*)(ws + OFF_R1);
        bf16_t* QD = (bf16_t*)(ws + OFF_QD); bf16_t* KD = (bf16_t*)(ws + OFF_KD); bf16_t* VTD = (bf16_t*)(ws + OFF_VTD);
        bf16_t* FT = (bf16_t*)(ws + OFF_FT); bf16_t* FTC = (bf16_t*)(ws + OFF_FTC);
        bf16_t* QM = (bf16_t*)(ws + OFF_QM); bf16_t* KM = (bf16_t*)(ws + OFF_KM); bf16_t* VTM = (bf16_t*)(ws + OFF_VTM);
        bf16_t* Y = (bf16_t*)(ws + OFF_Y); bf16_t* PQ = (bf16_t*)(ws + OFF_PQ); bf16_t* CKV = (bf16_t*)(ws + OFF_CKV);
        float* RSQ = (float*)(ws + OFF_RSQ); float* RSKV = (float*)(ws + OFF_RSKV);
        const float* RD = (const float*)(ws + OFF_ROPED); const float* RM = (const float*)(ws + OFF_ROPEM);
        const float* LAM = (const float*)(ws + OFF_LAM);
        const bf16_t* DFTL = (const bf16_t*)(ws + OFF_DFTL); const bf16_t* DFTC = (const bf16_t*)(ws + OFF_DFTC);

        if (ph == 0) { if (EN(12)) prologue(p, lds); }
        else if (ph == NPH - 1) { if (EN(13)) final_phase(p); }
        else {
            const int l = (ph - 1) / 12, sp = (ph - 1) % 12;
            const float* modl = (const float*)(ws + OFF_MOD) + (size_t)l * 9 * 9216;
            const bf16_t* W = (const bf16_t*)(ws + OFF_W) + (size_t)l * WE_END;
            pg8::Sched S; S.ns = 1; S.G = G; S.c = bid; S.rep = 1; S.za = 0; S.zb = 0;
            if (EN(0) && (sp == 0 || sp == 3 || sp == 9)) {
                const int ni = sp == 0 ? 0 : sp == 3 ? 1 : 2;
                norm_phase(p, p.norm_g + ((size_t)l * 3 + ni) * DM, modl, 3 * ni, 3 * ni + 1, sp == 3);
            } else if (EN(1) && (sp == 1 || sp == 10)) {
                const int s = sp == 1 ? 0 : 1;
                S.s0 = pg8::mksub(AN, W + WE_W1 + (size_t)s * 5632 * 1024, 72, 22, 1024, 1024);
                EpiSwiglu E{ACT};
                pg8::gemm_phase(lds, 1024, 1024, 1024, S, E);
            } else if (EN(2) && (sp == 2 || sp == 11)) {
                const int s = sp == 2 ? 0 : 1;
                S.s0 = pg8::mksub(ACT, W + WE_W2 + (size_t)s * 1024 * 2816, 72, 4, 2816, 2816);
                EpiResid E{H, modl, s == 0 ? 2 : 8, rep_ ? 0.f : 0.5f};
                pg8::gemm_phase(lds, 2816, 2816, 2816, S, E);
            } else if (EN(4) && sp == 4) {
                S.ns = 3;
                S.s0 = pg8::mksub(AN, W + WE_IN, 72, 19, 1024, 1024);
                S.s1 = pg8::mksub(W + WE_V, AN, 2, 72, 1024, 1024);
                S.s2 = pg8::mksub(W + WE_F, AN, 4, 72, 1024, 1024);
                EpiIn E{QD, KD, PQ, CKV, GT, KM, VTD, FT, FTC, RSQ, RSKV, RD, RM};
                pg8::gemm_phase(lds, 1024, 1024, 1024, S, E);
            } else if (EN(5) && sp == 5) {
                for (int cx = 0; cx < 2; ++cx) {
                    S.ns = cx ? 2 : 1; S.c = cx ? (bid + 216) % G : bid;
                    S.s0 = cx ? pg8::mksub(CKV, W + WE_UK, 72, 2, 256, 256) : pg8::mksub(PQ, W + WE_UQ, 72, 3, 512, 384);
                    S.s1 = pg8::mksub(W + WE_UV, CKV, 2, 72, 256, 256);
                    EpiUp E{QM, KM, VTM, RSQ, RSKV, RM, cx};
                    pg8::gemm_phase(lds, cx ? 256 : 384, cx ? 256 : 512, cx ? 256 : 384, S, E);
                }
            } else if (EN(6) && sp == 6) {
                const float lam = LAM[l], outfac = LAM[4 + l];
                if (AEN(0)) for (int i0 = bid; i0 < 288; i0 += G) {
                    const bool lat = i0 < 256; const int it = lat ? ((G == 256) ? ((i0 & 7) * 32 + (i0 >> 3)) : i0) : i0 - 256;
                    const int b = lat ? it >> 5 : it >> 2, h = lat ? (it >> 3) & 3 : it & 3, qt = it & 7;
                    const size_t rb = (size_t)b * TPB, r0 = lat ? rb + CTX + qt * 256 : rb;
                    attn_item<64, 128, true>(lds, QD + r0 * 512 + h * 128, 512, KD + rb * 512 + h * 128, 512, VTD + (size_t)(b * 4 + h) * 128 * TPB, lat ? TPB : CTX, 256,
                                             Y + r0 * 1536 + h * 128, lam, outfac, p.diff_subln_g + l * 128);
                }
                if (AEN(1)) for (int i1 = bid; i1 < 320; i1 += G) {
                    const int i0 = (i1 + 32) % 320;
                    const bool lat = i0 < 256; const int it = lat ? ((G == 256) ? ((i0 & 7) * 32 + (i0 >> 3)) : i0) : i0 - 256;
                    const int b = lat ? it >> 5 : it >> 3, h = lat ? (it >> 2) & 7 : it & 7, qt = it & 3;
                    const size_t rb = (size_t)b * TPB, r0 = lat ? rb + CTX + qt * 512 : rb;
                    attn_item<96, 64, false>(lds, QM + r0 * 768 + h * 96, 768, KM + rb * 768 + h * 96, 768, VTM + (size_t)(b * 8 + h) * 64 * TPB, lat ? TPB : CTX, lat ? 512 : 256,
                                             Y + r0 * 1536 + 512 + h * 64, 0.f, 1.f, nullptr);
                }
                __syncthreads();
                if (AEN(3)) for (int cx = 0; cx < 2; ++cx) {
                    const int Kf = cx ? 512 : 4096;
                    S.c = cx ? bid : (bid + 128) % G;
                    S.s0 = pg8::mksub(cx ? DFTC : DFTL, cx ? FTC : FT, cx ? 8 : 64, 2, Kf, Kf); S.s0.mmod = cx ? 1 : 8; S.s0.zb = (size_t)512 * Kf * 2;
                    EpiF2 E1{Y, cx};
                    pg8::gemm_phase(lds, Kf, Kf, Kf, S, E1);
                }
            } else if (EN(7) && sp == 7) {
                S.rep = 3; S.za = 512 * 2; S.zb = (size_t)1024 * 512 * 2;
                S.s0 = pg8::mksub(Y, W + WE_B, 72, 4, 1536, 512);
                EpiMerge E{MG, GT};
                pg8::gemm_phase(lds, 512, 1536, 512, S, E);
            } else if (EN(8) && sp == 8) {
                S.s0 = pg8::mksub(MG, W + WE_O, 72, 4, 1024, 1024);
                EpiResid E{H, modl, 5, rep_ ? 0.f : 1.0f};
                pg8::gemm_phase(lds, 1024, 1024, 1024, S, E);
            }
        }
        if (ph + 1 < p.ph_hi) { if (ph == 0 && rep_ == 0) cg::this_grid().sync(); else xcd_barrier(xbar); }
      }
    }
}

extern "C" void kernel_launch(void* const* d_in, const int* in_sizes, int n_in, void* d_out, int out_size, void* d_ws, size_t ws_size, hipStream_t stream) {
    static int grid = 0;
    if (grid == 0) {
        if (ws_size < WS_NEED) { fprintf(stderr, "kernel_launch: workspace too small: need %zu have %zu\n", (size_t)WS_NEED, ws_size); grid = -1; return; }
        int dev = 0, cus = 0, per_cu = 0;
        hipGetDevice(&dev); hipDeviceGetAttribute(&cus, hipDeviceAttributeMultiprocessorCount, dev);
        if (hipFuncSetAttribute((const void*)fwd_kernel, hipFuncAttributeMaxDynamicSharedMemorySize, LDS_BYTES) != hipSuccess) { fprintf(stderr, "kernel_launch: hipFuncSetAttribute failed\n"); grid = -1; return; }
        if (hipOccupancyMaxActiveBlocksPerMultiprocessor(&per_cu, (const void*)fwd_kernel, NT, LDS_BYTES) != hipSuccess || per_cu < 1) { fprintf(stderr, "kernel_launch: occupancy query says %d\n", per_cu); per_cu = 1; }
        (void)hipGetLastError();
        grid = cus * per_cu;
        fprintf(stderr, "kernel_launch: grid %d (cus %d x %d), ws need %zu have %zu\n", grid, cus, per_cu, (size_t)WS_NEED, ws_size);
    }
    if (grid < 0) return;
    Params p{};
    const float** pp = (const float**)&p;
    for (int i = 0; i < 21; ++i) pp[i] = (const float*)d_in[i];
    p.out = (float*)d_out; p.ws = (unsigned char*)d_ws;
#if ONE_LAUNCH
    if (hipMemsetAsync((char*)d_ws + OFF_BAR, 0, BAR_BYTES, stream) != hipSuccess) { fprintf(stderr, "kernel_launch: memset of the barrier words failed\n"); return; }
    p.ph_lo = 0; p.ph_hi = NPH;
    void* args[] = {&p};
    hipError_t e = hipLaunchCooperativeKernel((const void*)fwd_kernel, dim3(grid), dim3(NT), args, LDS_BYTES, stream);
    if (e != hipSuccess) fprintf(stderr, "cooperative launch failed: %s (grid %d)\n", hipGetErrorString(e), grid);
#else
    for (int ph = 0; ph < NPH; ++ph) {
        p.ph_lo = ph; p.ph_hi = ph + 1;
        hipLaunchKernelGGL(fwd_kernel, dim3(grid), dim3(NT), LDS_BYTES, stream, p);
    }
#endif
}
```

```cpp
#include <hip/hip_runtime.h>
#include <hip/hip_cooperative_groups.h>
#include <cstdio>
namespace cg = cooperative_groups;

#define REPS(ph) 1
#ifndef ONE_LAUNCH
#define ONE_LAUNCH 1
#endif

#define LAS __attribute__((address_space(3)))
#define DI __device__ __forceinline__
typedef unsigned short bf16_t;
typedef short bf16x8 __attribute__((ext_vector_type(8)));
typedef float f32x4 __attribute__((ext_vector_type(4)));
typedef float f32x16 __attribute__((ext_vector_type(16)));
typedef unsigned u32x4 __attribute__((ext_vector_type(4)));
typedef unsigned u32x2 __attribute__((ext_vector_type(2)));

constexpr int DM = 1024, NB = 8, SEQ = 2048, CTX = 256, TPB = SEQ + CTX  , T = NB * TPB  ;
constexpr int DEPTH = 4, DFF = 2816, INW = 5792, NMOD = 9;
constexpr int NT = 512;
constexpr int YW = 2048;
constexpr int LDS_MAIN = 147456;
constexpr int LDS_BYTES = LDS_MAIN + 256;
constexpr float RMS_EPS = 1e-6f;

constexpr size_t al256(size_t x) { return (x + 255) & ~(size_t)255; }
constexpr size_t OFF_H = 0;
constexpr size_t OFF_AN = OFF_H + (size_t)T * DM * 4;
constexpr size_t OFF_R1 = OFF_AN + (size_t)T * DM * 2;
constexpr size_t OFF_QD = OFF_R1 + (size_t)T * 3072 * 2;
constexpr size_t OFF_KD = OFF_QD + (size_t)T * 512 * 2;
constexpr size_t OFF_VTD = OFF_KD + (size_t)T * 512 * 2;
constexpr size_t OFF_FT = OFF_VTD + (size_t)T * 512 * 2;
constexpr size_t OFF_FTC = OFF_FT + (size_t)NB * 512 * 4096 * 2;
constexpr size_t OFF_QM = OFF_FTC + (size_t)NB * 512 * 512 * 2;
constexpr size_t OFF_KM = OFF_QM + (size_t)T * 768 * 2;
constexpr size_t OFF_VTM = OFF_KM + (size_t)T * 768 * 2;
constexpr size_t OFF_Y = OFF_VTM + (size_t)T * 512 * 2;
constexpr size_t OFF_PQ = OFF_Y;
constexpr size_t OFF_CKV = OFF_PQ + (size_t)T * 512 * 2;
constexpr size_t OFF_RSQ = OFF_Y + (size_t)T * YW * 2;
constexpr size_t OFF_RSKV = OFF_RSQ + (size_t)T * 4;
constexpr size_t OFF_MOD = OFF_RSKV + (size_t)T * 4;
constexpr size_t OFF_ROPED = OFF_MOD + (size_t)DEPTH * 9 * 9216 * 4;
constexpr size_t OFF_ROPEM = OFF_ROPED + (size_t)2048 * 32 * 8;
constexpr size_t OFF_LAM = OFF_ROPEM + (size_t)2048 * 16 * 8;
constexpr size_t OFF_DFTL = OFF_LAM + 256;
constexpr size_t OFF_DFTC = OFF_DFTL + (size_t)2048 * 4096 * 2;
constexpr size_t OFF_W = OFF_DFTC + (size_t)256 * 512 * 2;
constexpr size_t WE_W1 = 0;
constexpr size_t WE_W2 = WE_W1 + (size_t)2 * 5632 * 1024;
constexpr size_t WE_IN = WE_W2 + (size_t)2 * 1024 * 2816;
constexpr size_t WE_V = WE_IN + (size_t)4864 * 1024;
constexpr size_t WE_F = WE_V + (size_t)512 * 1024;
constexpr size_t WE_UQ = WE_F + (size_t)1024 * 1024;
constexpr size_t WE_UK = WE_UQ + (size_t)768 * 384;
constexpr size_t WE_UV = WE_UK + (size_t)512 * 256;
constexpr size_t WE_B = WE_UV + (size_t)512 * 256;
constexpr size_t WE_O = WE_B + (size_t)1024 * 2048;
constexpr size_t WE_END = WE_O + (size_t)1024 * 1024;
constexpr size_t OFF_BAR = OFF_W + (size_t)DEPTH * WE_END * 2;
constexpr size_t BAR_BYTES = 3456 * 4;
constexpr size_t WS_NEED = OFF_BAR + BAR_BYTES;

struct Params {
    const float *x, *c, *ctx, *c_ctx, *ada_w, *ada_b, *norm_g, *ffn_w_in, *ffn_w_out, *w_in, *diff_lambda, *diff_subln_g, *mla_q_norm_g, *mla_w_uq,
        *mla_kv_norm_g, *mla_w_ukv, *w_bd, *w_bm, *w_bf, *w_out, *final_g;
    float* out; unsigned char* ws; int ph_lo, ph_hi;
};

DI unsigned pk2(float a, float b) {
    typedef float f2 __attribute__((ext_vector_type(2))); typedef __bf16 b2 __attribute__((ext_vector_type(2)));
    f2 v = {a, b}; b2 r = __builtin_convertvector(v, b2); return __builtin_bit_cast(unsigned, r);
}
DI float bflo(unsigned w) { return __uint_as_float(w << 16); }
DI float bfhi(unsigned w) { return __uint_as_float(w & 0xffff0000u); }
DI void store8(bf16_t* p, f32x4 a, f32x4 b) { u32x4 w = {pk2(a[0], a[1]), pk2(a[2], a[3]), pk2(b[0], b[1]), pk2(b[2], b[3])}; *(u32x4*)p = w; }
DI void load8(const bf16_t* p, f32x4& a, f32x4& b) { const u32x4 w = *(const u32x4*)p; a = (f32x4){bflo(w.x), bfhi(w.x), bflo(w.y), bfhi(w.y)}; b = (f32x4){bflo(w.z), bfhi(w.z), bflo(w.w), bfhi(w.w)}; }
DI float fast_exp2(float x) { return __builtin_amdgcn_exp2f(x); }
DI float sigmoidf_(float x) { return __builtin_amdgcn_rcpf(1.0f + fast_exp2(-1.44269504f * x)); }
DI float wave_sum(float v) { v += __shfl_xor(v, 32); v += __shfl_xor(v, 16); v += __shfl_xor(v, 8); v += __shfl_xor(v, 4); v += __shfl_xor(v, 2); v += __shfl_xor(v, 1); return v; }

DI void rope4(f32x4& v, const float* tab, float sg, int xm) {
    f32x4 q;
#pragma unroll
    for (int i = 0; i < 4; ++i) q[i] = __shfl_xor(v[i], xm);
    const f32x4 t0 = *(const f32x4*)tab, t1 = *(const f32x4*)(tab + 4);
    v[0] = v[0] * t0[0] + sg * q[0] * t0[1]; v[1] = v[1] * t0[2] + sg * q[1] * t0[3];
    v[2] = v[2] * t1[0] + sg * q[2] * t1[1]; v[3] = v[3] * t1[2] + sg * q[3] * t1[3];
}
DI void rope8(f32x4& v0, f32x4& v1, const float* tab, bool first, int xm) {
    const float sg = first ? -1.f : 1.f;
    rope4(v0, tab, sg, xm); asm volatile("" ::: "memory");
    rope4(v1, tab + 8, sg, xm); asm volatile("" ::: "memory");
}

namespace pg8 {
constexpr int BM = 256, BK = 64, HALF = 128, HTB = HALF * BK * 2, STAGE_BYTES = 8 * HTB;
DI int lds_byte(int r, int c) { const int st = (r >> 4) * 2 + (c >> 5), rr = r & 15, cc = c & 31, ob = rr * 64 + cc * 2; return st * 1024 + (ob ^ (((ob >> 9) & 1) << 5)); }
DI void stage_rc(int b, int& R, int& C) { const int st = b / 1024, sb = b % 1024, swz = sb ^ (((sb >> 9) & 1) << 5); R = (st >> 1) * 16 + swz / 64; C = (st & 1) * 32 + (swz % 64) / 2; }
DI int perm32(int rho) { const int n = rho >> 4, i = rho & 15; return 8 * (i >> 2) + 4 * n + (i & 3); }

struct Unit { const char* a; const char* b; int pm, pn, s, z; };

struct Sub { const char* A; const char* B; int nM, nN, mmod, mode, mapM, mapN, ksplit; size_t tsa, tsb, zb, kbytes; };
struct Sched {
    Sub s0, s1, s2; int ns, G, c, rep; size_t za, zb;
    static DI int panel(int map, int p) { return map == 1 ? (p >> 3) * 9 + 1 + (p & 7) : map == 2 ? p * 9 : p; }
    DI bool pick(const Sub& S, int sid, long& L, int z, Unit& u) const {
        const long cnt = (long)S.nM * S.nN * S.ksplit;
        if (L >= cnt) { L -= cnt; return false; }
        const int w = (int)L / S.ksplit, zk = (int)L - w * S.ksplit, nig = 8 * S.nN, gid = w / nig, fm = gid * 8, gsz = (S.nM - fm) < 8 ? (S.nM - fm) : 8;
        u.pm = panel(S.mapM, fm + ((w % nig) % gsz)); u.pn = panel(S.mapN, (w % nig) / gsz); u.s = sid; u.z = z + zk;
        if (S.mode == 1) { const int q = u.pm >> 3; u.a = S.A + (size_t)(u.pm & 7) * S.tsa + (size_t)(q & 1) * 4096; u.b = S.B + (size_t)u.pn * S.tsb + (size_t)(q >> 1) * S.zb + (size_t)(q & 1) * 4096; }
        else {
        u.a = S.A + (size_t)(u.pm % S.mmod) * S.tsa + (size_t)z * za;
        u.b = S.B + (size_t)u.pn * S.tsb + (size_t)(u.pm / S.mmod) * S.zb + (size_t)z * zb; }
        u.a += (size_t)zk * S.kbytes; u.b += (size_t)zk * S.kbytes;
        return true;
    }
    DI bool next(int i, Unit& u) const {
        const int j = i / rep, z = i - j * rep;
        long L = (long)j * G + c;
        if (pick(s0, 0, L, z, u)) return true;
        if (ns > 1 && pick(s1, 1, L, z, u)) return true;
        if (ns > 2 && pick(s2, 2, L, z, u)) return true;
        return false;
    }
};
DI Sub mksub(const void* A, const void* B, int nM, int nN, int lda, int ldb) { Sub s; s.A = (const char*)A; s.B = (const char*)B; s.nM = nM; s.nN = nN; s.mmod = 1 << 30; s.mode = 0; s.mapM = 0; s.mapN = 0; s.ksplit = 1; s.kbytes = 0; s.tsa = (size_t)256 * lda * 2; s.tsb = (size_t)256 * ldb * 2; s.zb = 0; return s; }

template <class Epi>
DI void gemm_phase(LAS unsigned char* lds, const int K, const int lda, const int ldb, const Sched& S, const Epi& E) {
    int tid = threadIdx.x; asm volatile("" : "+v"(tid));
    const int wid = __builtin_amdgcn_readfirstlane(tid >> 6), lane = tid & 63, wr = wid >> 2, wc = wid & 3, fr = lane & 15, fq = lane >> 4;
    const int nt = K / BK;
    unsigned voffA[2], voffB[2];
#pragma unroll
    for (int i = 0; i < 2; ++i) { int R, C; stage_rc(tid * 16 + i * 8192, R, C); const int Rb = Epi::PERM ? ((R & ~31) + perm32(R & 31)) : R;
        voffA[i] = (unsigned)(R * lda + C) * 2u; voffB[i] = (unsigned)(Rb * ldb + C) * 2u; }
    const size_t kstep = (size_t)(BK * 2);
    const size_t hsA = (size_t)HALF * lda * 2, hsB = (size_t)HALF * ldb * 2;
    const unsigned ldsw = (unsigned)wid * 1024u;
    const int aoff = lds_byte(wr * 64 + fr, fq * 8), boff = lds_byte(wc * 32 + fr, fq * 8);
#define PG8_SA(b, h) (((b) * 2 + (h)) * HTB)
#define PG8_SB(b, h) ((4 + (b) * 2 + (h)) * HTB)
#define PG8_STAGE(bufoff, gbase, voff) do { _Pragma("unroll") for (int _i = 0; _i < 2; ++_i) \
        __builtin_amdgcn_global_load_lds((const unsigned*)((const char*)(gbase) + (voff)[_i]), (LAS unsigned*)(lds + (bufoff) + ldsw + _i * 8192), 16, 0, 0); } while (0)
#define PG8_LDA(dst, b, h) do { _Pragma("unroll") for (int m = 0; m < 4; ++m) _Pragma("unroll") for (int k = 0; k < 2; ++k) dst[m][k] = *(const LAS bf16x8*)(lds + PG8_SA(b, h) + aoff + m * 2048 + k * 1024); } while (0)
#define PG8_LDB(dst, b, h) do { _Pragma("unroll") for (int n = 0; n < 2; ++n) _Pragma("unroll") for (int k = 0; k < 2; ++k) dst[n][k] = *(const LAS bf16x8*)(lds + PG8_SB(b, h) + boff + n * 2048 + k * 1024); } while (0)
#define PG8_MMA(ai, bj, At, Bt) do { __builtin_amdgcn_s_setprio(1); _Pragma("unroll") for (int m = 0; m < 4; ++m) _Pragma("unroll") for (int n = 0; n < 2; ++n) _Pragma("unroll") for (int k = 0; k < 2; ++k) \
        acc[ai][bj][m][n] = __builtin_amdgcn_mfma_f32_16x16x32_bf16(Bt[n][k], At[m][k], acc[ai][bj][m][n], 0, 0, 0); __builtin_amdgcn_s_setprio(0); } while (0)
#define PG8_WAIT_V(n) asm volatile("s_waitcnt vmcnt(" #n ")" ::: "memory")
#define PG8_WAIT_L(n) asm volatile("s_waitcnt lgkmcnt(" #n ")" ::: "memory")
#define PG8_BAR __builtin_amdgcn_s_barrier()
#define PG8_SCHED __builtin_amdgcn_sched_barrier(0)
    Unit cur, nxt; int ui = 0;
    if (!S.next(0, cur)) return;
    f32x4 acc[2][2][4][2];
#pragma unroll
    for (int a = 0; a < 2; ++a)
#pragma unroll
        for (int b = 0; b < 2; ++b)
#pragma unroll
            for (int m = 0; m < 4; ++m)
#pragma unroll
                for (int n = 0; n < 2; ++n) acc[a][b][m][n] = (f32x4){0.f, 0.f, 0.f, 0.f};
    bf16x8 At[4][2], B0[2][2], B1[2][2];
    const char* cA = cur.a; const char* cB = cur.b;
    PG8_STAGE(PG8_SB(0, 0), cB, voffB); PG8_STAGE(PG8_SA(0, 0), cA, voffA); PG8_STAGE(PG8_SB(0, 1), cB + hsB, voffB); PG8_STAGE(PG8_SA(0, 1), cA + hsA, voffA);
    if (wr == 1) PG8_BAR;
    PG8_WAIT_V(4); PG8_BAR;
    PG8_STAGE(PG8_SB(1, 0), cB + kstep, voffB); PG8_STAGE(PG8_SA(1, 0), cA + kstep, voffA); PG8_STAGE(PG8_SB(1, 1), cB + hsB + kstep, voffB);
    PG8_WAIT_V(6); PG8_BAR;
    for (;;) {
        const bool has_next = S.next(ui + 1, nxt);
        const char* nA = has_next ? nxt.a : cA; const char* nB = has_next ? nxt.b : cB;
        for (int t = 0; t < nt; t += 2) {
            const bool last = (t == nt - 2);
            if constexpr (Epi::MID) { if (t == 8 || t == 16) { int fr2 = fr, fq2 = fq; asm volatile("" : "+v"(fr2), "+v"(fq2)); E.mid(acc, cur, t == 16 ? 1 : 0, wr, wc, fr2, fq2); } }
            const char* a1 = cA + (size_t)(t + 1) * kstep;
            const char* a2 = last ? nA : cA + (size_t)(t + 2) * kstep; const char* b2 = last ? nB : cB + (size_t)(t + 2) * kstep;
            const char* a3 = a2 + kstep; const char* b3 = b2 + kstep;
            PG8_LDB(B0, 0, 0); PG8_SCHED; PG8_LDA(At, 0, 0); PG8_STAGE(PG8_SA(1, 1), a1 + hsA, voffA);
            PG8_WAIT_L(8); PG8_BAR; PG8_WAIT_L(0); PG8_MMA(0, 0, At, B0); PG8_BAR; PG8_SCHED;
            PG8_LDB(B1, 0, 1); PG8_STAGE(PG8_SB(0, 0), b2, voffB);
            PG8_BAR; PG8_WAIT_L(0); PG8_MMA(0, 1, At, B1); PG8_BAR;
            PG8_LDA(At, 0, 1); PG8_STAGE(PG8_SA(0, 0), a2, voffA);
            PG8_BAR; PG8_WAIT_L(0); PG8_MMA(1, 0, At, B0); PG8_BAR; PG8_SCHED;
            PG8_STAGE(PG8_SB(0, 1), b2 + hsB, voffB);
            PG8_WAIT_V(6); PG8_BAR; PG8_MMA(1, 1, At, B1); PG8_BAR;
            PG8_LDB(B0, 1, 0); PG8_SCHED; PG8_LDA(At, 1, 0); PG8_STAGE(PG8_SA(0, 1), a2 + hsA, voffA);
            PG8_WAIT_L(8); PG8_BAR; PG8_WAIT_L(0); PG8_MMA(0, 0, At, B0); PG8_BAR; PG8_SCHED;
            PG8_LDB(B1, 1, 1); PG8_STAGE(PG8_SB(1, 0), b3, voffB);
            PG8_BAR; PG8_WAIT_L(0); PG8_MMA(0, 1, At, B1); PG8_BAR;
            PG8_LDA(At, 1, 1); PG8_STAGE(PG8_SA(1, 0), a3, voffA);
            PG8_BAR; PG8_WAIT_L(0); PG8_MMA(1, 0, At, B0); PG8_BAR; PG8_SCHED;
            PG8_STAGE(PG8_SB(1, 1), b3 + hsB, voffB);
            PG8_WAIT_V(6); PG8_BAR; PG8_MMA(1, 1, At, B1); PG8_BAR;
        }
        { int fr2 = fr, fq2 = fq; asm volatile("" : "+v"(fr2), "+v"(fq2));
          E(acc, cur, wr, wc, fr2, fq2); }
        if (!has_next) break;
#pragma unroll
        for (int a = 0; a < 2; ++a)
#pragma unroll
            for (int b = 0; b < 2; ++b)
#pragma unroll
                for (int m = 0; m < 4; ++m)
#pragma unroll
                    for (int n = 0; n < 2; ++n) acc[a][b][m][n] = (f32x4){0.f, 0.f, 0.f, 0.f};
        cur = nxt; cA = nA; cB = nB; ++ui;
    }
    PG8_WAIT_V(0);
    if (wr == 0) PG8_BAR;
    PG8_BAR;
#undef PG8_SA
#undef PG8_SB
#undef PG8_STAGE
#undef PG8_LDA
#undef PG8_LDB
#undef PG8_MMA
#undef PG8_WAIT_V
#undef PG8_WAIT_L
#undef PG8_BAR
#undef PG8_SCHED
}
}
using pg8::Unit;
typedef const f32x4 (&AccRef)[2][2][4][2];

struct EpiSwiglu {
    static constexpr bool PERM = true, MID = false;
    bf16_t* ACT;
    DI void operator()(AccRef acc, const Unit& u, int wr, int wc, int fr, int fq) const {
        const int row0 = u.pm * 256 + wr * 64 + fr, col0 = u.pn * 128 + wc * 32 + 8 * fq;
#pragma unroll
        for (int ai = 0; ai < 2; ++ai)
#pragma unroll
            for (int m = 0; m < 4; ++m) {
                f32x4 o[2];
#pragma unroll
                for (int n = 0; n < 2; ++n)
#pragma unroll
                    for (int i = 0; i < 4; ++i) { const float g = acc[ai][0][m][n][i]; o[n][i] = g * sigmoidf_(g) * acc[ai][1][m][n][i]; }
                store8(ACT + (size_t)(row0 + ai * 128 + m * 16) * DFF + col0, o[0], o[1]);
            }
    }
};
struct EpiResid {
    static constexpr bool PERM = false, MID = false;
    float* H; const float* modl; int gidx; float fac; int atomic;
    DI void operator()(AccRef acc, const Unit& u, int wr, int wc, int fr, int fq) const {
        const int mrow = (u.pm % 9 == 0) ? 8 : u.pm / 9;
        const float* gate = modl + (size_t)mrow * 9216 + gidx * 1024;
        const int row0 = u.pm * 256 + wr * 64 + fr, col0 = u.pn * 256 + wc * 32 + 4 * fq;
        f32x4 gv[2][2];
#pragma unroll
        for (int bj = 0; bj < 2; ++bj)
#pragma unroll
            for (int n = 0; n < 2; ++n) gv[bj][n] = *(const f32x4*)(gate + col0 + bj * 128 + n * 16) * fac;
#pragma unroll
        for (int ai = 0; ai < 2; ++ai)
#pragma unroll
            for (int m = 0; m < 4; ++m) {
                float* rowp = H + (size_t)(row0 + ai * 128 + m * 16) * DM + col0;
#pragma unroll
                for (int bj = 0; bj < 2; ++bj)
#pragma unroll
                    for (int n = 0; n < 2; ++n) { f32x4* p = (f32x4*)(rowp + bj * 128 + n * 16); const f32x4 v = gv[bj][n] * acc[ai][bj][m][n];
                        if (atomic) { unsafeAtomicAdd((float*)p, v[0]); unsafeAtomicAdd((float*)p + 1, v[1]); unsafeAtomicAdd((float*)p + 2, v[2]); unsafeAtomicAdd((float*)p + 3, v[3]); }
                        else *p = *p + v; }
            }
    }
};
struct EpiIn {
    static constexpr bool PERM = true, MID = false;
    bf16_t *QD, *KD, *PQ, *CKV, *G, *KM, *VTD, *FT, *FTC; float *rsq, *rskv; const float *RD, *RM;
    DI void operator()(AccRef acc, const Unit& u, int wr, int wc, int fr, int fq) const {
        if (u.s == 0) {
            const int pn = u.pn, tt = u.pm % 9; const bool lat = tt != 0;
            const int rl0 = wr * 64 + fr;
            if (pn < 4) {
                bf16_t* dst = (pn < 2) ? QD : KD;
                const int colb = (pn & 1) * 256 + wc * 32 + 8 * fq, sel = wc & 1; const bool first = (fq >> 1) == 0;
#pragma unroll
                for (int ai = 0; ai < 2; ++ai)
#pragma unroll
                    for (int m = 0; m < 4; ++m) {
                        const int rl = rl0 + ai * 128 + m * 16; const size_t row = (size_t)u.pm * 256 + rl; const int pos = (tt - 1) * 256 + rl;
#pragma unroll
                        for (int bj = 0; bj < 2; ++bj) {
                            f32x4 v0 = acc[ai][bj][m][0], v1 = acc[ai][bj][m][1];
                            if (lat) rope8(v0, v1, RD + ((size_t)pos * 32 + sel * 16 + 8 * (fq & 1)) * 2, first, 32);
                            store8(dst + row * 512 + colb + bj * 128, v0, v1);
                            asm volatile("" ::: "memory");
                        }
                    }
            } else if (pn < 6) {
#pragma unroll
                for (int ai = 0; ai < 2; ++ai)
#pragma unroll
                    for (int m = 0; m < 4; ++m) {
                        const int rl = rl0 + ai * 128 + m * 16; const size_t row = (size_t)u.pm * 256 + rl; const int pos = (tt - 1) * 256 + rl;
#pragma unroll
                        for (int bj = 0; bj < 2; ++bj) {
                            f32x4 v0 = acc[ai][bj][m][0], v1 = acc[ai][bj][m][1];
                            const int c = (pn - 4) * 256 + bj * 128 + wc * 32;
                            if (c < 384) {
                                float ss = v0[0] * v0[0] + v0[1] * v0[1] + v0[2] * v0[2] + v0[3] * v0[3] + v1[0] * v1[0] + v1[1] * v1[1] + v1[2] * v1[2] + v1[3] * v1[3];
                                ss += __shfl_xor(ss, 16); ss += __shfl_xor(ss, 32);
                                if (fq == 0) atomicAdd(rsq + row, ss);
                                store8(PQ + row * 512 + c + 8 * fq, v0, v1);
                            } else if (c == 384) {
                                if (lat) rope8(v0, v1, RM + ((size_t)pos * 16 + (fq >> 1) * 8) * 2, (fq & 1) == 0, 16);
#pragma unroll
                                for (int h = 0; h < 8; ++h) store8(KM + row * 768 + h * 96 + 64 + 8 * fq, v0, v1);
                            }
                            asm volatile("" ::: "memory");
                        }
                    }
            } else if (pn == 6) {
#pragma unroll
                for (int ai = 0; ai < 2; ++ai)
#pragma unroll
                    for (int m = 0; m < 4; ++m) {
                        const size_t row = (size_t)u.pm * 256 + rl0 + ai * 128 + m * 16;
#pragma unroll
                        for (int bj = 0; bj < 2; ++bj) {
                            const f32x4 v0 = acc[ai][bj][m][0], v1 = acc[ai][bj][m][1];
                            float ss = v0[0] * v0[0] + v0[1] * v0[1] + v0[2] * v0[2] + v0[3] * v0[3] + v1[0] * v1[0] + v1[1] * v1[1] + v1[2] * v1[2] + v1[3] * v1[3];
                            ss += __shfl_xor(ss, 16); ss += __shfl_xor(ss, 32);
                            if (fq == 0) atomicAdd(rskv + row, ss);
                            store8(CKV + row * 256 + bj * 128 + wc * 32 + 8 * fq, v0, v1);
                            asm volatile("" ::: "memory");
                        }
                    }
            } else {
                const int colb = (pn - 7) * 256 + wc * 32 + 8 * fq;
#pragma unroll
                for (int ai = 0; ai < 2; ++ai)
#pragma unroll
                    for (int m = 0; m < 4; ++m) {
                        const size_t row = (size_t)u.pm * 256 + rl0 + ai * 128 + m * 16;
#pragma unroll
                        for (int bj = 0; bj < 2; ++bj) {
                            f32x4 v0 = acc[ai][bj][m][0], v1 = acc[ai][bj][m][1];
#pragma unroll
                            for (int i = 0; i < 4; ++i) { v0[i] = sigmoidf_(v0[i]); v1[i] = sigmoidf_(v1[i]); }
                            store8(G + row * 3072 + colb + bj * 128, v0, v1);
                        }
                    }
            }
        } else {
            const int b = u.pn / 9, tt = u.pn % 9, cl = wc * 32 + 8 * fq;
#pragma unroll
            for (int ai = 0; ai < 2; ++ai)
#pragma unroll
                for (int m = 0; m < 4; ++m) {
                    const int r = u.pm * 256 + ai * 128 + wr * 64 + m * 16 + fr;
                    bf16_t* dst;
                    if (u.s == 1) dst = VTD + ((size_t)(b * 4 + (r >> 7)) * 128 + (r & 127)) * TPB + tt * 256;
                    else {
                        const int g = r >> 8, part = (r >> 7) & 1, mm = r & 127;
                        dst = (tt == 0) ? FTC + ((size_t)(b * 512 + g * 128 + mm) * 512 + part * 256)
                                        : FT + ((size_t)(b * 512 + g * 128 + mm) * 4096 + part * 2048 + (tt - 1) * 256);
                    }
#pragma unroll
                    for (int bj = 0; bj < 2; ++bj) store8(dst + bj * 128 + cl, acc[ai][bj][m][0], acc[ai][bj][m][1]);
                }
        }
    }
};
struct EpiUp {
    static constexpr bool PERM = true, MID = false;
    bf16_t *QM, *KM, *VTM; const float *rsq, *rskv, *RM; int mode;
    DI void operator()(AccRef acc, const Unit& u, int wr, int wc, int fr, int fq) const {
        if (mode == 0) {
            const int tt = u.pm % 9; const bool lat = tt != 0; const int rl0 = wr * 64 + fr;
#pragma unroll
            for (int ai = 0; ai < 2; ++ai)
#pragma unroll
                for (int m = 0; m < 4; ++m) {
                    const int rl = rl0 + ai * 128 + m * 16; const size_t row = (size_t)u.pm * 256 + rl; const int pos = (tt - 1) * 256 + rl;
                    const float rs = __builtin_amdgcn_rsqf(rsq[row] * (1.0f / 384.0f) + RMS_EPS);
#pragma unroll
                    for (int bj = 0; bj < 2; ++bj) {
                        const int c = u.pn * 256 + bj * 128 + wc * 32;
                        f32x4 v0 = acc[ai][bj][m][0] * rs, v1 = acc[ai][bj][m][1] * rs;
                        if (((c >> 5) % 3) == 2 && lat) rope8(v0, v1, RM + ((size_t)pos * 16 + (fq >> 1) * 8) * 2, (fq & 1) == 0, 16);
                        store8(QM + row * 768 + c + 8 * fq, v0, v1);
                    }
                    asm volatile("" ::: "memory");
                }
        } else if (u.s == 0) {
#pragma unroll
            for (int ai = 0; ai < 2; ++ai)
#pragma unroll
                for (int m = 0; m < 4; ++m) {
                    const size_t row = (size_t)u.pm * 256 + wr * 64 + fr + ai * 128 + m * 16;
                    const float rs = __builtin_amdgcn_rsqf(rskv[row] * (1.0f / 256.0f) + RMS_EPS);
#pragma unroll
                    for (int bj = 0; bj < 2; ++bj) {
                        const int c = u.pn * 256 + bj * 128 + wc * 32 + 8 * fq;
                        store8(KM + row * 768 + (c >> 6) * 96 + (c & 63), acc[ai][bj][m][0] * rs, acc[ai][bj][m][1] * rs);
                    }
                    asm volatile("" ::: "memory");
                }
        } else {
            const int b = u.pn / 9, tt = u.pn % 9, cl = wc * 32 + 8 * fq;
#pragma unroll
            for (int bj = 0; bj < 2; ++bj) {
                f32x4 rs[2];
#pragma unroll
                for (int n = 0; n < 2; ++n) {
                    const f32x4 q = *(const f32x4*)(rskv + (size_t)u.pn * 256 + bj * 128 + cl + 4 * n);
#pragma unroll
                    for (int i = 0; i < 4; ++i) rs[n][i] = __builtin_amdgcn_rsqf(q[i] * (1.0f / 256.0f) + RMS_EPS);
                }
#pragma unroll
                for (int ai = 0; ai < 2; ++ai)
#pragma unroll
                    for (int m = 0; m < 4; ++m) {
                        const int r = u.pm * 256 + ai * 128 + wr * 64 + m * 16 + fr;
                        bf16_t* dst = VTM + ((size_t)(b * 8 + (r >> 6)) * 64 + (r & 63)) * TPB + tt * 256;
                        store8(dst + bj * 128 + cl, acc[ai][bj][m][0] * rs[0], acc[ai][bj][m][1] * rs[1]);
                    }
                asm volatile("" ::: "memory");
            }
        }
    }
};
struct EpiF2 {
    static constexpr bool PERM = true, MID = false;
    bf16_t* Y; int ctx;
    DI void operator()(AccRef acc, const Unit& u, int wr, int wc, int fr, int fq) const {
        const int q = u.pm >> 3;
        const size_t rowb = ctx ? (size_t)u.pm * TPB : (size_t)(q >> 1) * TPB + 256 + (u.pm & 7) * 256;
        const int colb = 1024 + (ctx ? 0 : (q & 1) * 512) + u.pn * 256 + wc * 32 + 8 * fq;
#pragma unroll
        for (int ai = 0; ai < 2; ++ai)
#pragma unroll
            for (int m = 0; m < 4; ++m) {
                const size_t row = rowb + wr * 64 + fr + ai * 128 + m * 16;
#pragma unroll
                for (int bj = 0; bj < 2; ++bj) {
                    store8(Y + row * YW + colb + bj * 128, acc[ai][bj][m][0], acc[ai][bj][m][1]);
                    if (ctx) *(u32x4*)(Y + row * YW + colb + bj * 128 + 512) = (u32x4){0u, 0u, 0u, 0u};
                }
            }
    }
};
struct EpiMerge {
    static constexpr bool PERM = true, MID = true;
    bf16_t* MG; const bf16_t* G;
    DI void mid(f32x4 (&acc)[2][2][4][2], const Unit& u, int which, int wr, int wc, int fr, int fq) const {
#pragma unroll
        for (int ai = 0; ai < 2; ++ai)
#pragma unroll
            for (int m = 0; m < 4; ++m) {
                const size_t row = (size_t)u.pm * 256 + wr * 64 + fr + ai * 128 + m * 16;
#pragma unroll
                for (int bj = 0; bj < 2; ++bj) {
                    const int c = u.pn * 256 + bj * 128 + wc * 32 + 8 * fq;
                    f32x4 a0, a1, b0, b1; load8(G + row * 3072 + which * 1024 + c, a0, a1); load8(G + row * 3072 + (which + 1) * 1024 + c, b0, b1);
#pragma unroll
                    for (int i = 0; i < 4; ++i) { acc[ai][bj][m][0][i] *= a0[i] * __builtin_amdgcn_rcpf(b0[i]); acc[ai][bj][m][1][i] *= a1[i] * __builtin_amdgcn_rcpf(b1[i]); }
                }
                asm volatile("" ::: "memory");
            }
    }
    DI void operator()(AccRef acc, const Unit& u, int wr, int wc, int fr, int fq) const {
#pragma unroll
        for (int ai = 0; ai < 2; ++ai)
#pragma unroll
            for (int m = 0; m < 4; ++m) {
                const size_t row = (size_t)u.pm * 256 + wr * 64 + fr + ai * 128 + m * 16;
#pragma unroll
                for (int bj = 0; bj < 2; ++bj) {
                    const int c = u.pn * 256 + bj * 128 + wc * 32 + 8 * fq;
                    f32x4 g0, g1; load8(G + row * 3072 + 2048 + c, g0, g1);
                    store8(MG + row * 1024 + c, g0 * acc[ai][bj][m][0], g1 * acc[ai][bj][m][1]);
                }
            }
    }
};

#define MFMA32(a, b, c) __builtin_amdgcn_mfma_f32_32x32x16_bf16((a), (b), (c), 0, 0, 0)
template <int D, int DV, bool DIFF>
DI void attn_item(LAS unsigned char* lds, const bf16_t* Qb, int ldq, const bf16_t* Kb, int ldk, const bf16_t* VT, int nkeys, int nq,
                  bf16_t* Yb, float lam, float outfac, const float* subg) {
    constexpr int KROW = (DIFF ? 256 : 192) + 16, VROW = 144, KBYTES = 64 * KROW, VBYTES = DV * VROW, STAGE = KBYTES + VBYTES;
    constexpr int KCH = DIFF ? 16 : 12, NKC = 64 * KCH, NVC = DV * 8, NKK = D / 16, NDVB = DV / 32;
    int tid = threadIdx.x; asm volatile("" : "+v"(tid));
    const int wave = __builtin_amdgcn_readfirstlane(tid >> 6), lane = tid & 63, l32 = lane & 31, half = lane >> 5;
    const float cs = (DIFF ? 0.125f : 0.10206207261596575f) * 1.4426950408889634f;
    const bool active = DIFF ? true : (wave * 64 < nq);
    bf16x8 qf[2][DIFF ? 1 : NKK];
    const LAS unsigned char* qlds = lds + 2 * STAGE + (wave * 32 + l32) * KROW + half * 16;
    if (DIFF) {
#pragma unroll
        for (int i = 0; i < 8; ++i) { const int ch = tid + i * NT, r = ch >> 4, cc = ch & 15;
            *(LAS u32x4*)(lds + 2 * STAGE + r * KROW + cc * 16) = *(const u32x4*)(Qb + (size_t)r * ldq + cc * 8); }
    } else {
#pragma unroll
        for (int s = 0; s < 2; ++s)
#pragma unroll
            for (int kk = 0; kk < NKK; ++kk) {
                const int qr = wave * 64 + s * 32 + l32, qc = kk * 16 + half * 8;
                qf[s][DIFF ? 0 : kk] = active ? *(const bf16x8*)(Qb + (size_t)qr * ldq + qc) : (bf16x8){0, 0, 0, 0, 0, 0, 0, 0};
            }
    }
    f32x16 O[2][NDVB];
#pragma unroll
    for (int s = 0; s < 2; ++s)
#pragma unroll
        for (int d = 0; d < NDVB; ++d)
#pragma unroll
            for (int i = 0; i < 16; ++i) O[s][d][i] = 0.f;
    float mrun[2] = {-1e30f, -1e30f}, lsum[2] = {0.f, 0.f};
    const int nt = nkeys / 64;
    u32x4 kr[2], vr[2];
    const int kc0 = tid, kc1 = tid + NT;
    const bool k1ok = kc1 < NKC, v1ok = (tid + NT) < NVC;
    const int krow0 = kc0 / KCH, kcc0 = kc0 % KCH, krow1 = kc1 / KCH, kcc1 = kc1 % KCH;
    const int vrow0 = tid >> 3, vcc0 = tid & 7, vrow1 = (tid + NT) >> 3;
#define ATT_LOAD(t) do { const int key0 = (t) * 64; \
        kr[0] = *(const u32x4*)(Kb + (size_t)(key0 + krow0) * ldk + kcc0 * 8); \
        if (k1ok) kr[1] = *(const u32x4*)(Kb + (size_t)(key0 + krow1) * ldk + kcc1 * 8); \
        vr[0] = *(const u32x4*)(VT + (size_t)vrow0 * TPB + key0 + vcc0 * 8); \
        if (v1ok) vr[1] = *(const u32x4*)(VT + (size_t)vrow1 * TPB + key0 + vcc0 * 8); } while (0)
#define ATT_WRITE(st) do { LAS unsigned char* sb = lds + (st) * STAGE; \
        *(LAS u32x4*)(sb + krow0 * KROW + kcc0 * 16) = kr[0]; \
        if (k1ok) *(LAS u32x4*)(sb + krow1 * KROW + kcc1 * 16) = kr[1]; \
        *(LAS u32x4*)(sb + KBYTES + vrow0 * VROW + vcc0 * 16) = vr[0]; \
        if (v1ok) *(LAS u32x4*)(sb + KBYTES + vrow1 * VROW + vcc0 * 16) = vr[1]; } while (0)
    ATT_LOAD(0); ATT_WRITE(0); __syncthreads();
    for (int t = 0; t < nt; ++t) {
        if (t + 1 < nt) ATT_LOAD(t + 1);
        if (active) {
            const LAS unsigned char* sb = lds + (t & 1) * STAGE;
#pragma unroll
            for (int kb = 0; kb < 2; ++kb) {
                bf16x8 P[2][2];
                f32x16 S[2];
                if (!DIFF) {
#pragma unroll
                    for (int s = 0; s < 2; ++s)
#pragma unroll
                        for (int i = 0; i < 16; ++i) S[s][i] = 0.f;
#pragma unroll
                    for (int kk = 0; kk < NKK; ++kk) {
                        const bf16x8 kf = *(const LAS bf16x8*)(sb + (kb * 32 + l32) * KROW + (kk * 16 + half * 8) * 2);
                        S[0] = MFMA32(kf, qf[0][DIFF ? 0 : kk], S[0]); S[1] = MFMA32(kf, qf[1][DIFF ? 0 : kk], S[1]);
                    }
                }
#pragma unroll
                for (int s = 0; s < 2; ++s) {
                    if (DIFF) {
#pragma unroll
                        for (int i = 0; i < 16; ++i) S[s][i] = 0.f;
#pragma unroll
                        for (int kk = 0; kk < NKK; ++kk) {
                            const bf16x8 kf = *(const LAS bf16x8*)(sb + (kb * 32 + l32) * KROW + (s * 64 + kk * 16 + half * 8) * 2);
                            const bf16x8 qq = *(const LAS bf16x8*)(qlds + (s * 64 + kk * 16) * 2);
                            S[s] = MFMA32(kf, qq, S[s]);
                        }
                    }
                    float mx = S[s][0];
#pragma unroll
                    for (int i = 1; i < 16; ++i) mx = fmaxf(mx, S[s][i]);
                    mx = fmaxf(mx, __shfl_xor(mx, 32));
                    const float mt2 = mx * cs;
                    if (__builtin_amdgcn_ballot_w64(mt2 > mrun[s] + 8.0f) != 0ull) {
                        const float mnew = fmaxf(mrun[s], mt2), alpha = fast_exp2(mrun[s] - mnew);
                        lsum[s] *= alpha;
#pragma unroll
                        for (int d = 0; d < NDVB; ++d)
#pragma unroll
                            for (int i = 0; i < 16; ++i) O[s][d][i] *= alpha;
                        mrun[s] = mnew;
                    }
                    float ls = 0.f;
#pragma unroll
                    for (int i = 0; i < 16; ++i) { S[s][i] = fast_exp2(S[s][i] * cs - mrun[s]); ls += S[s][i]; }
                    lsum[s] += ls;
#pragma unroll
                    for (int k2 = 0; k2 < 2; ++k2) {
                        u32x4 w = {pk2(S[s][8 * k2], S[s][8 * k2 + 1]), pk2(S[s][8 * k2 + 2], S[s][8 * k2 + 3]), pk2(S[s][8 * k2 + 4], S[s][8 * k2 + 5]), pk2(S[s][8 * k2 + 6], S[s][8 * k2 + 7])};
                        P[s][k2] = __builtin_bit_cast(bf16x8, w);
                    }
                    if (DIFF) asm volatile("" ::: "memory");
                }
#pragma unroll
                for (int d = 0; d < NDVB; ++d)
#pragma unroll
                    for (int k2 = 0; k2 < 2; ++k2) {
                        const LAS unsigned char* va = sb + KBYTES + (d * 32 + l32) * VROW + (kb * 32 + k2 * 16 + half * 4) * 2;
                        const u32x2 lo = *(const LAS u32x2*)va, hi = *(const LAS u32x2*)(va + 16);
                        const u32x4 w = {lo.x, lo.y, hi.x, hi.y};
                        const bf16x8 vf = __builtin_bit_cast(bf16x8, w);
                        O[0][d] = MFMA32(vf, P[0][k2], O[0][d]); O[1][d] = MFMA32(vf, P[1][k2], O[1][d]);
                        if (DIFF) asm volatile("" ::: "memory");
                    }
            }
        }
        if (t + 1 < nt) ATT_WRITE((t + 1) & 1);
        __syncthreads();
    }
#undef ATT_LOAD
#undef ATT_WRITE
    if (!active) return;
    int l32e = l32, halfe = half; asm volatile("" : "+v"(l32e), "+v"(halfe));
    float inv[2];
#pragma unroll
    for (int s = 0; s < 2; ++s) { const float l = lsum[s] + __shfl_xor(lsum[s], 32); inv[s] = 1.0f / l; }
    if (DIFF) {
        float ss = 0.f;
#pragma unroll
        for (int d = 0; d < NDVB; ++d)
#pragma unroll
            for (int i = 0; i < 16; ++i) { const float o = O[0][d][i] * inv[0] - lam * (O[1][d][i] * inv[1]); O[0][d][i] = o; ss += o * o; }
        ss += __shfl_xor(ss, 32);
        const float rs = __builtin_amdgcn_rsqf(ss * (1.0f / 128.0f) + RMS_EPS) * outfac;
        bf16_t* yr = Yb + (size_t)(wave * 32 + l32e) * YW;
#pragma unroll
        for (int d = 0; d < NDVB; ++d)
#pragma unroll
            for (int g4 = 0; g4 < 4; ++g4) {
                const int dv = d * 32 + g4 * 8 + halfe * 4;
                const f32x4 gg = *(const f32x4*)(subg + dv);
                u32x2 w = {pk2(O[0][d][4 * g4] * rs * gg[0], O[0][d][4 * g4 + 1] * rs * gg[1]), pk2(O[0][d][4 * g4 + 2] * rs * gg[2], O[0][d][4 * g4 + 3] * rs * gg[3])};
                *(u32x2*)(yr + dv) = w;
            }
    } else {
#pragma unroll
        for (int s = 0; s < 2; ++s) {
            bf16_t* yr = Yb + (size_t)(wave * 64 + s * 32 + l32e) * YW;
#pragma unroll
            for (int d = 0; d < NDVB; ++d)
#pragma unroll
                for (int g4 = 0; g4 < 4; ++g4) {
                    const int dv = d * 32 + g4 * 8 + halfe * 4;
                    u32x2 w = {pk2(O[s][d][4 * g4] * inv[s], O[s][d][4 * g4 + 1] * inv[s]), pk2(O[s][d][4 * g4 + 2] * inv[s], O[s][d][4 * g4 + 3] * inv[s])};
                    *(u32x2*)(yr + dv) = w;
                }
        }
    }
}

DI int mapcol(int kind, int n) {
    switch (kind) {
        case 1: { const int pn = n >> 8, r = n & 255; return r < 128 ? pn * 128 + r : DFF + pn * 128 + (r - 128); }
        case 2: return n < 1024 ? n : n < 1408 ? 1536 + (n - 1024) : n < 1440 ? 2176 + (n - 1408) : n < 1536 ? -1 : n < 1792 ? 1920 + (n - 1536) : 2720 + (n - 1792);
        case 3: return 1024 + n;
        case 4: return (n >> 6) * 128 + (n & 63);
        case 5: return (n >> 6) * 128 + 64 + (n & 63);
        default: return n;
    }
}
DI void prepT(LAS float* tile, bf16_t* dst, int ldd, const float* src, int lds_, int Kd, int Nd, int kind, const float* kscale, int& rot) {
    int tid = threadIdx.x; asm volatile("" : "+v"(tid));
    const int G = gridDim.x, ntk = Kd >> 6, ntiles = ntk * (Nd >> 6);
    for (int t = (int)((blockIdx.x + (unsigned)G - (unsigned)(rot % G)) % (unsigned)G); t < ntiles; t += G) {
        const int k0 = (t % ntk) << 6, n0 = (t / ntk) << 6;
        const int nn = tid & 63, sc = mapcol(kind, n0 + nn);
#pragma unroll
        for (int ps = 0; ps < 8; ++ps) {
            const int kk = ps * 8 + (tid >> 6);
            float v = sc >= 0 ? src[(size_t)(k0 + kk) * lds_ + sc] : 0.f;
            if (kscale) v *= kscale[k0 + kk];
            tile[kk * 65 + nn] = v;
        }
        __syncthreads();
        const int on = tid >> 3, kc = tid & 7;
        u32x4 w;
        w.x = pk2(tile[(kc * 8 + 0) * 65 + on], tile[(kc * 8 + 1) * 65 + on]); w.y = pk2(tile[(kc * 8 + 2) * 65 + on], tile[(kc * 8 + 3) * 65 + on]);
        w.z = pk2(tile[(kc * 8 + 4) * 65 + on], tile[(kc * 8 + 5) * 65 + on]); w.w = pk2(tile[(kc * 8 + 6) * 65 + on], tile[(kc * 8 + 7) * 65 + on]);
        *(u32x4*)(dst + (size_t)(n0 + on) * ldd + k0 + kc * 8) = w;
        __syncthreads();
    }
    rot += ntiles;
}

DI void prologue(const Params& p, LAS unsigned char* lds) {
    int tid = threadIdx.x; asm volatile("" : "+v"(tid));
    const int G = gridDim.x, bid = blockIdx.x;
    const size_t gtid = (size_t)bid * NT + tid, gsz = (size_t)G * NT;
    unsigned char* ws = p.ws;
    {
        f32x4* H = (f32x4*)(ws + OFF_H);
        for (size_t i = gtid; i < (size_t)T * 256; i += gsz) {
            const int t = (int)(i >> 8), c4 = (int)(i & 255), b = t / TPB, r = t - b * TPB;
            H[i] = r < CTX ? ((const f32x4*)p.ctx)[((size_t)b * CTX + r) * 256 + c4] : ((const f32x4*)p.x)[((size_t)b * SEQ + (r - CTX)) * 256 + c4];
        }
    }
    {
        float* RD = (float*)(ws + OFF_ROPED); float* RM = (float*)(ws + OFF_ROPEM);
        for (size_t i = gtid; i < (size_t)2048 * 32; i += gsz) {
            const int pos = (int)(i >> 5), e = (int)(i & 31), sel = e >> 4, j = e & 15;
            const float fr = __powf(10000.f, -(float)j / 16.f), ang = (float)(sel ? (pos & 63) : (pos >> 6)) * fr, rev = ang * 0.15915494309189535f;
            RD[2 * i] = __builtin_amdgcn_cosf(rev); RD[2 * i + 1] = __builtin_amdgcn_sinf(rev);
        }
        for (size_t i = gtid; i < (size_t)2048 * 16; i += gsz) {
            const int pos = (int)(i >> 4), e = (int)(i & 15), sel = e >> 3, j = e & 7;
            const float fr = __powf(10000.f, -(float)j / 8.f), ang = (float)(sel ? (pos & 63) : (pos >> 6)) * fr, rev = ang * 0.15915494309189535f;
            RM[2 * i] = __builtin_amdgcn_cosf(rev); RM[2 * i + 1] = __builtin_amdgcn_sinf(rev);
        }
    }
    {
        u32x4* DL = (u32x4*)(ws + OFF_DFTL);
        for (size_t i = gtid; i < (size_t)2048 * 512; i += gsz) {
            const int k = (int)(i >> 9), c8 = (int)(i & 511) * 8, part = c8 >> 11, n0 = c8 & 2047;
            float v[8];
#pragma unroll
            for (int j = 0; j < 8; ++j) { const float fr = (float)((k * (n0 + j)) & 2047) * (1.0f / 2048.0f);
                v[j] = (part ? -__builtin_amdgcn_sinf(fr) : __builtin_amdgcn_cosf(fr)) * 0.022097086912079608f; }
            DL[i] = (u32x4){pk2(v[0], v[1]), pk2(v[2], v[3]), pk2(v[4], v[5]), pk2(v[6], v[7])};
        }
        u32x4* DC = (u32x4*)(ws + OFF_DFTC);
        for (size_t i = gtid; i < (size_t)256 * 64; i += gsz) {
            const int k = (int)(i >> 6), c8 = (int)(i & 63) * 8, part = c8 >> 8, n0 = c8 & 255;
            float v[8];
#pragma unroll
            for (int j = 0; j < 8; ++j) { const float fr = (float)((k * (n0 + j)) & 255) * (1.0f / 256.0f);
                v[j] = (part ? -__builtin_amdgcn_sinf(fr) : __builtin_amdgcn_cosf(fr)) * 0.0625f; }
            DC[i] = (u32x4){pk2(v[0], v[1]), pk2(v[2], v[3]), pk2(v[4], v[5]), pk2(v[6], v[7])};
        }
    }
    if (bid == 0 && tid < DEPTH) {
        const float* dl = p.diff_lambda + tid * 4 * 64; float a = 0.f, b = 0.f;
        for (int i = 0; i < 64; ++i) { a += dl[i] * dl[64 + i]; b += dl[128 + i] * dl[192 + i]; }
        const float lam_init = 0.8f - 0.6f * expf(-0.3f * (float)tid);
        ((float*)(ws + OFF_LAM))[tid] = expf(a) - expf(b) + lam_init;
        ((float*)(ws + OFF_LAM))[4 + tid] = 1.0f - lam_init;
    }
    {
        LAS float* sc = (LAS float*)lds;
        LAS float* red = (LAS float*)(lds + 40960);
        for (int i = tid; i < 9 * 1024; i += NT) { const float v = i < 8192 ? p.c[i] : p.c_ctx[i - 8192]; sc[i] = v * sigmoidf_(v); }
        __syncthreads();
        float* MOD = (float*)(ws + OFF_MOD);
        for (int it = bid; it < DEPTH * 144; it += G) {
            const int l = it / 144, n0 = (it % 144) * 64, col = tid & 63, kg = tid >> 6;
            const float* w = p.ada_w + (size_t)l * 1024 * 9216 + n0 + col;
            float a[9];
#pragma unroll
            for (int r = 0; r < 9; ++r) a[r] = 0.f;
            for (int k = kg * 128; k < kg * 128 + 128; ++k) {
                const float wv = w[(size_t)k * 9216];
#pragma unroll
                for (int r = 0; r < 9; ++r) a[r] += sc[r * 1024 + k] * wv;
            }
#pragma unroll
            for (int r = 0; r < 9; ++r) red[(kg * 9 + r) * 64 + col] = a[r];
            __syncthreads();
            for (int o = tid; o < 576; o += NT) {
                const int r = o >> 6, cc = o & 63; float s = p.ada_b[l * 9216 + n0 + cc];
#pragma unroll
                for (int g = 0; g < 8; ++g) s += red[(g * 9 + r) * 64 + cc];
                MOD[((size_t)l * 9 + r) * 9216 + n0 + cc] = s;
            }
            __syncthreads();
        }
    }
    {
        LAS float* wt = (LAS float*)lds;
        LAS float* tc = (LAS float*)(lds + 16384);
        LAS bf16_t* ot = (LAS bf16_t*)(lds + 20480);
        for (int i = tid; i < 128; i += NT) { tc[i] = __builtin_amdgcn_cosf((float)i * (1.0f / 128.0f)); tc[128 + i] = __builtin_amdgcn_sinf((float)i * (1.0f / 128.0f)); }
        for (int it = bid; it < DEPTH * 4 * 32; it += G) {
            const int l = it >> 7, g = (it >> 5) & 3, k0 = (it & 31) * 32;
            __syncthreads();
            for (int i = tid; i < 32 * 128; i += NT) wt[i] = p.w_in[((size_t)l * 1024 + k0 + (i >> 7)) * INW + 2208 + g * 128 + (i & 127)];
            __syncthreads();
            const int pmi = tid & 255, part = pmi >> 7, m = pmi & 127, kh = tid >> 8;
            float a[16];
#pragma unroll
            for (int i = 0; i < 16; ++i) a[i] = 0.f;
            for (int c = 0; c < 128; ++c) {
                const float tv = tc[part * 128 + ((m * c) & 127)];
#pragma unroll
                for (int i = 0; i < 16; ++i) a[i] += wt[(2 * i + kh) * 128 + c] * tv;
            }
#pragma unroll
            for (int i = 0; i < 16; ++i) { const unsigned w = pk2(a[i] * 0.08838834764831845f, 0.f); ot[pmi * 32 + 2 * i + kh] = (bf16_t)(w & 0xffffu); }
            __syncthreads();
            bf16_t* AF = (bf16_t*)(ws + OFF_W) + (size_t)l * WE_END + WE_F;
            for (int ch = tid; ch < 1024; ch += NT) {
                const int r = ch >> 2, q = ch & 3;
                *(u32x4*)(AF + (size_t)(g * 256 + r) * 1024 + k0 + q * 8) = *(const LAS u32x4*)(ot + r * 32 + q * 8);
            }
        }
        __syncthreads();
    }
    {
        LAS float* tile = (LAS float*)lds; int rot = 0;
        for (int l = 0; l < DEPTH; ++l) {
            bf16_t* W = (bf16_t*)(ws + OFF_W) + (size_t)l * WE_END;
            for (int s = 0; s < 2; ++s) {
                prepT(tile, W + WE_W1 + (size_t)s * 5632 * 1024, 1024, p.ffn_w_in + ((size_t)l * 2 + s) * 1024 * 5632, 5632, 1024, 5632, 1, nullptr, rot);
                prepT(tile, W + WE_W2 + (size_t)s * 1024 * 2816, 2816, p.ffn_w_out + ((size_t)l * 2 + s) * 2816 * 1024, 1024, 2816, 1024, 0, nullptr, rot);
            }
            const float* win = p.w_in + (size_t)l * 1024 * INW;
            prepT(tile, W + WE_IN, 1024, win, INW, 1024, 4864, 2, nullptr, rot);
            prepT(tile, W + WE_V, 1024, win, INW, 1024, 512, 3, nullptr, rot);
            prepT(tile, W + WE_UQ, 384, p.mla_w_uq + (size_t)l * 384 * 768, 768, 384, 768, 0, p.mla_q_norm_g + l * 384, rot);
            prepT(tile, W + WE_UK, 256, p.mla_w_ukv + (size_t)l * 256 * 1024, 1024, 256, 512, 4, p.mla_kv_norm_g + l * 256, rot);
            prepT(tile, W + WE_UV, 256, p.mla_w_ukv + (size_t)l * 256 * 1024, 1024, 256, 512, 5, p.mla_kv_norm_g + l * 256, rot);
            prepT(tile, W + WE_B, 2048, p.w_bd + (size_t)l * 512 * 1024, 1024, 512, 1024, 0, nullptr, rot);
            prepT(tile, W + WE_B + 512, 2048, p.w_bm + (size_t)l * 512 * 1024, 1024, 512, 1024, 0, nullptr, rot);
            prepT(tile, W + WE_B + 1024, 2048, p.w_bf + (size_t)l * 512 * 1024, 1024, 512, 1024, 0, nullptr, rot);
            prepT(tile, W + WE_B + 1536, 2048, p.w_bf + (size_t)l * 512 * 1024, 1024, 512, 1024, 0, nullptr, rot);
            prepT(tile, W + WE_O, 1024, p.w_out + (size_t)l * 1024 * 1024, 1024, 1024, 1024, 0, nullptr, rot);
        }
    }
}

DI void norm_phase(const Params& p, const float* gain, const float* modl, int sh_i, int sc_i, bool zero) {
    int tid = threadIdx.x; asm volatile("" : "+v"(tid));
    const int lane = tid & 63, gw = blockIdx.x * 8 + (tid >> 6), nw = gridDim.x * 8;
    const float* H = (const float*)(p.ws + OFF_H); bf16_t* AN = (bf16_t*)(p.ws + OFF_AN);
    f32x4 g[4];
#pragma unroll
    for (int j = 0; j < 4; ++j) g[j] = *(const f32x4*)(gain + (lane + 64 * j) * 4);
    for (int t0 = gw; t0 < T; t0 += nw * 4) {
        f32x4 v[4][4]; float ss[4];
#pragma unroll
        for (int r = 0; r < 4; ++r) {
            const int t = t0 + r * nw; const bool ok = t < T;
            const f32x4* hr = (const f32x4*)(H + (size_t)(ok ? t : t0) * DM);
#pragma unroll
            for (int j = 0; j < 4; ++j) v[r][j] = hr[lane + 64 * j];
        }
#pragma unroll
        for (int r = 0; r < 4; ++r) {
            float s = 0.f;
#pragma unroll
            for (int j = 0; j < 4; ++j) s += v[r][j][0] * v[r][j][0] + v[r][j][1] * v[r][j][1] + v[r][j][2] * v[r][j][2] + v[r][j][3] * v[r][j][3];
            ss[r] = wave_sum(s);
        }
#pragma unroll
        for (int r = 0; r < 4; ++r) {
            const int t = t0 + r * nw;
            if (t < T) {
                const float rs = __builtin_amdgcn_rsqf(ss[r] * (1.0f / 1024.0f) + RMS_EPS);
                const int b = t / TPB, rr = t - b * TPB, mrow = rr < CTX ? 8 : b;
                const float* sh = modl + (size_t)mrow * 9216 + sh_i * 1024; const float* sc = modl + (size_t)mrow * 9216 + sc_i * 1024;
#pragma unroll
                for (int j = 0; j < 4; ++j) {
                    const int c = (lane + 64 * j) * 4;
                    const f32x4 s1 = *(const f32x4*)(sc + c), s0 = *(const f32x4*)(sh + c);
                    const f32x4 y = (v[r][j] * rs * g[j]) * (s1 + 1.0f) + s0;
                    *(u32x2*)(AN + (size_t)t * DM + c) = (u32x2){pk2(y[0], y[1]), pk2(y[2], y[3])};
                }
            }
        }
    }
    if (zero) {
        float* a = (float*)(p.ws + OFF_RSQ);
        for (size_t i = (size_t)blockIdx.x * NT + tid; i < (size_t)2 * T; i += (size_t)gridDim.x * NT) a[i] = 0.f;
    }
}
DI void final_phase(const Params& p) {
    int tid = threadIdx.x; asm volatile("" : "+v"(tid));
    const int lane = tid & 63, gw = blockIdx.x * 8 + (tid >> 6), nw = gridDim.x * 8;
    const float* H = (const float*)(p.ws + OFF_H);
    for (int q = gw; q < NB * SEQ; q += nw) {
        const int b = q >> 11, n = q & 2047;
        const f32x4* hr = (const f32x4*)(H + ((size_t)b * TPB + CTX + n) * DM);
        f32x4 v[4]; float ss = 0.f;
#pragma unroll
        for (int j = 0; j < 4; ++j) { v[j] = hr[lane + 64 * j]; ss += v[j][0] * v[j][0] + v[j][1] * v[j][1] + v[j][2] * v[j][2] + v[j][3] * v[j][3]; }
        ss = wave_sum(ss);
        const float rs = __builtin_amdgcn_rsqf(ss * (1.0f / 1024.0f) + RMS_EPS);
#pragma unroll
        for (int j = 0; j < 4; ++j) { const int c = (lane + 64 * j) * 4; *(f32x4*)(p.out + (size_t)q * DM + c) = v[j] * rs * *(const f32x4*)(p.final_g + c); }
    }
}

#define XB_TMO      128
#define XB_XCNT(j)  (256  + 64 * (j))
#define XB_XSUB(j)  (1280 + 64 * (j))
#define XB_XGEN(j)  (2304 + 64 * (j))
#define XB_TOP      3328
#define XB_TOPGEN   3392
#define XB_SPIN_CAP (1u << 22)
DI unsigned xb_ld(unsigned* p) { return __hip_atomic_load(p, __ATOMIC_RELAXED, __HIP_MEMORY_SCOPE_AGENT); }
DI unsigned xb_add(unsigned* p, unsigned v) { return __hip_atomic_fetch_add(p, v, __ATOMIC_RELAXED, __HIP_MEMORY_SCOPE_AGENT); }
DI unsigned xb_xcc_id() { return (unsigned)__builtin_amdgcn_s_getreg((3 << 11) | 20) & 0xFu; }
#define XB_SPIN(cond, bar) do { unsigned _sp = 0; while (cond) { __builtin_amdgcn_s_sleep(1); \
    if ((++_sp & 255u) == 0u) { if (xb_ld(&(bar)[XB_TMO])) break; if (_sp > XB_SPIN_CAP) { atomicAdd(&(bar)[XB_TMO], 1u); break; } } } } while (0)
struct XcdBarrier { unsigned* bar; unsigned x; volatile LAS unsigned* st; };
DI XcdBarrier xcd_barrier_post(unsigned* bar, volatile LAS unsigned* st) {
    XcdBarrier b; b.bar = bar; b.x = xb_xcc_id(); b.st = st;
    if (threadIdx.x == 0) (void)xb_add(&bar[XB_XCNT(b.x)], 1u);
    return b;
}
DI void xcd_barrier_complete(unsigned* bar, unsigned x, unsigned& nloc, unsigned& nx) {
    const unsigned G = gridDim.x * gridDim.y * gridDim.z;
    unsigned sum, cnt, mine, sp = 0u;
    for (;;) {
        sum = 0u; cnt = 0u; mine = 0u;
#pragma unroll
        for (unsigned j = 0; j < 16; ++j) { const unsigned c = xb_ld(&bar[XB_XCNT(j)]); sum += c; cnt += (c > 0u) ? 1u : 0u; mine = (j == x) ? c : mine; }
        if (sum == G) break;
        __builtin_amdgcn_s_sleep(1);
        if ((++sp & 255u) == 0u) { if (xb_ld(&bar[XB_TMO])) break; if (sp > XB_SPIN_CAP) { atomicAdd(&bar[XB_TMO], 1u); break; } }
    }
    nloc = mine > 0u ? mine : 1u; nx = cnt > 0u ? cnt : 1u;
}
DI void xcd_barrier(const XcdBarrier& b) {
    asm volatile("s_waitcnt vmcnt(0)" ::: "memory");
    __syncthreads();
    if (threadIdx.x == 0) {
        unsigned* bar = b.bar;
        __builtin_amdgcn_s_waitcnt(0);
        unsigned nloc = b.st[0], nx = b.st[1];
        if (nloc == 0u) { xcd_barrier_complete(bar, b.x, nloc, nx); b.st[0] = nloc; b.st[1] = nx; }
        const unsigned old = xb_add(&bar[XB_XSUB(b.x)], 1u);
        const unsigned gen = old / nloc;
        if (old + 1u == (gen + 1u) * nloc) {
            __builtin_amdgcn_fence(__ATOMIC_RELEASE, "agent");
            asm volatile("s_waitcnt vmcnt(0)" ::: "memory");
            const unsigned og = xb_add(&bar[XB_TOP], 1u);
            const unsigned tg = og / nx;
            if (og + 1u == (tg + 1u) * nx) xb_add(&bar[XB_TOPGEN], 1u);
            else XB_SPIN(xb_ld(&bar[XB_TOPGEN]) == tg, bar);
            __builtin_amdgcn_fence(__ATOMIC_ACQUIRE, "agent");
            xb_add(&bar[XB_XGEN(b.x)], 1u);
            asm volatile("s_waitcnt vmcnt(0)" ::: "memory");
        } else {
            XB_SPIN(xb_ld(&bar[XB_XGEN(b.x)]) == gen, bar);
            __builtin_amdgcn_fence(__ATOMIC_ACQUIRE, "agent");
            asm volatile("s_waitcnt vmcnt(0)" ::: "memory");
        }
    }
    __syncthreads();
}

constexpr int NPH = 2 + 12 * DEPTH;
#ifndef PH_MASK
#define PH_MASK 0xffff
#endif
#define EN(k) (((PH_MASK) >> (k)) & 1)
#ifndef ATT_MASK
#define ATT_MASK 0xf
#endif
#define AEN(k) (((ATT_MASK) >> (k)) & 1)
__global__ void __launch_bounds__(NT, 2) fwd_kernel(Params p) {
    extern __shared__ __attribute__((aligned(16))) unsigned char shm[];
    LAS unsigned char* lds = (LAS unsigned char*)shm;
    const int G = gridDim.x, bid = blockIdx.x;
    if (threadIdx.x < 4) ((LAS unsigned*)(lds + LDS_MAIN))[threadIdx.x] = 0u;
    __syncthreads();
    XcdBarrier xbar = xcd_barrier_post((unsigned*)(p.ws + OFF_BAR), (volatile LAS unsigned*)(lds + LDS_MAIN));
    for (int ph = p.ph_lo; ph < p.ph_hi; ++ph) {
      for (int rep_ = 0; rep_ < REPS(ph); ++rep_) {
        unsigned char* ws = p.ws; asm volatile("" : "+s"(ws));
        float* H = (float*)(ws + OFF_H); bf16_t* AN = (bf16_t*)(ws + OFF_AN); bf16_t* MG = AN;
        bf16_t* ACT = (bf16_t*)(ws + OFF_R1); bf16_t* GT = (bf16_t*)(ws + OFF_R1);
        bf16_t* QD = (bf16_t*)(ws + OFF_QD); bf16_t* KD = (bf16_t*)(ws + OFF_KD); bf16_t* VTD = (bf16_t*)(ws + OFF_VTD);
        bf16_t* FT = (bf16_t*)(ws + OFF_FT); bf16_t* FTC = (bf16_t*)(ws + OFF_FTC);
        bf16_t* QM = (bf16_t*)(ws + OFF_QM); bf16_t* KM = (bf16_t*)(ws + OFF_KM); bf16_t* VTM = (bf16_t*)(ws + OFF_VTM);
        bf16_t* Y = (bf16_t*)(ws + OFF_Y); bf16_t* PQ = (bf16_t*)(ws + OFF_PQ); bf16_t* CKV = (bf16_t*)(ws + OFF_CKV);
        float* RSQ = (float*)(ws + OFF_RSQ); float* RSKV = (float*)(ws + OFF_RSKV);
        const float* RD = (const float*)(ws + OFF_ROPED); const float* RM = (const float*)(ws + OFF_ROPEM);
        const float* LAM = (const float*)(ws + OFF_LAM);
        const bf16_t* DFTL = (const bf16_t*)(ws + OFF_DFTL); const bf16_t* DFTC = (const bf16_t*)(ws + OFF_DFTC);

        if (ph == 0) { if (EN(12)) prologue(p, lds); }
        else if (ph == NPH - 1) { if (EN(13)) final_phase(p); }
        else {
            const int l = (ph - 1) / 12, sp = (ph - 1) % 12;
            const float* modl = (const float*)(ws + OFF_MOD) + (size_t)l * 9 * 9216;
            const bf16_t* W = (const bf16_t*)(ws + OFF_W) + (size_t)l * WE_END;
            pg8::Sched S; S.ns = 1; S.G = G; S.c = bid; S.rep = 1; S.za = 0; S.zb = 0;
            if (EN(0) && (sp == 0 || sp == 3 || sp == 9)) {
                const int ni = sp == 0 ? 0 : sp == 3 ? 1 : 2;
                norm_phase(p, p.norm_g + ((size_t)l * 3 + ni) * DM, modl, 3 * ni, 3 * ni + 1, sp == 3);
            } else if (EN(1) && (sp == 1 || sp == 10)) {
                const int s = sp == 1 ? 0 : 1; const bool lo = (l == DEPTH - 1 && s == 1);
                S.s0 = pg8::mksub(AN, W + WE_W1 + (size_t)s * 5632 * 1024, lo ? 64 : 72, 22, 1024, 1024); S.s0.mapM = lo ? 1 : 0;
                EpiSwiglu E{ACT};
                pg8::gemm_phase(lds, 1024, 1024, 1024, S, E);
            } else if (EN(2) && (sp == 2 || sp == 11)) {
                const int s = sp == 2 ? 0 : 1; const bool lo = (l == DEPTH - 1 && s == 1);
                S.s0 = pg8::mksub(ACT, W + WE_W2 + (size_t)s * 1024 * 2816, lo ? 64 : 72, 4, 2816, 2816); S.s0.mapM = lo ? 1 : 0;
                EpiResid E{H, modl, s == 0 ? 2 : 8, rep_ ? 0.f : 0.5f, 0};
                pg8::gemm_phase(lds, 2816, 2816, 2816, S, E);
            } else if (EN(4) && sp == 4) {
                S.ns = 3;
                S.s0 = pg8::mksub(AN, W + WE_IN, 72, 19, 1024, 1024);
                S.s1 = pg8::mksub(W + WE_V, AN, 2, 72, 1024, 1024);
                S.s2 = pg8::mksub(W + WE_F, AN, 4, 72, 1024, 1024);
                EpiIn E{QD, KD, PQ, CKV, GT, KM, VTD, FT, FTC, RSQ, RSKV, RD, RM};
                pg8::gemm_phase(lds, 1024, 1024, 1024, S, E);
            } else if (EN(5) && sp == 5) {
                for (int cx = 0; cx < 2; ++cx) {
                    S.ns = cx ? 2 : 1; S.c = cx ? (bid + 216) % G : bid;
                    S.s0 = cx ? pg8::mksub(CKV, W + WE_UK, 72, 2, 256, 256) : pg8::mksub(PQ, W + WE_UQ, 72, 3, 512, 384);
                    S.s1 = pg8::mksub(W + WE_UV, CKV, 2, 72, 256, 256);
                    EpiUp E{QM, KM, VTM, RSQ, RSKV, RM, cx};
                    pg8::gemm_phase(lds, cx ? 256 : 384, cx ? 256 : 512, cx ? 256 : 384, S, E);
                }
            } else if (EN(6) && sp == 6) {
                const float lam = LAM[l], outfac = LAM[4 + l];
                const bool lastl = (l == DEPTH - 1);
                if (AEN(0)) for (int i0 = bid; i0 < (lastl ? 256 : 288); i0 += G) {
                    const bool lat = i0 < 256; const int it = lat ? ((G == 256) ? ((i0 & 7) * 32 + (i0 >> 3)) : i0) : i0 - 256;
                    const int b = lat ? it >> 5 : it >> 2, h = lat ? (it >> 3) & 3 : it & 3, qt = it & 7;
                    const size_t rb = (size_t)b * TPB, r0 = lat ? rb + CTX + qt * 256 : rb;
                    attn_item<64, 128, true>(lds, QD + r0 * 512 + h * 128, 512, KD + rb * 512 + h * 128, 512, VTD + (size_t)(b * 4 + h) * 128 * TPB, lat ? TPB : CTX, 256,
                                             Y + r0 * YW + h * 128, lam, outfac, p.diff_subln_g + l * 128);
                }
                if (AEN(1)) for (int i1 = bid; i1 < (lastl ? 256 : 320); i1 += G) {
                    const int i0 = lastl ? i1 : (i1 + 32) % 320;
                    const bool lat = i0 < 256; const int it = lat ? ((G == 256) ? ((i0 & 7) * 32 + (i0 >> 3)) : i0) : i0 - 256;
                    const int b = lat ? it >> 5 : it >> 3, h = lat ? (it >> 2) & 7 : it & 7, qt = it & 3;
                    const size_t rb = (size_t)b * TPB, r0 = lat ? rb + CTX + qt * 512 : rb;
                    attn_item<96, 64, false>(lds, QM + r0 * 768 + h * 96, 768, KM + rb * 768 + h * 96, 768, VTM + (size_t)(b * 8 + h) * 64 * TPB, lat ? TPB : CTX, lat ? 512 : 256,
                                             Y + r0 * YW + 512 + h * 64, 0.f, 1.f, nullptr);
                }
                __syncthreads();
                if (AEN(3)) for (int cx = 0; cx < (lastl ? 1 : 2); ++cx) {
                    const int Kf = cx ? 512 : 2048, ldf = cx ? 512 : 4096;
                    S.c = cx ? (bid + 240) % G : bid;
                    S.s0 = pg8::mksub(cx ? DFTC : DFTL, cx ? FTC : FT, cx ? 8 : 128, 2, ldf, ldf); S.s0.mmod = cx ? 1 : 8; S.s0.mode = cx ? 0 : 1; S.s0.zb = (size_t)512 * ldf * 2;
                    EpiF2 E1{Y, cx};
                    pg8::gemm_phase(lds, Kf, ldf, ldf, S, E1);
                }
            } else if (EN(7) && sp == 7) {
                const bool lo = (l == DEPTH - 1);
                S.s0 = pg8::mksub(Y, W + WE_B, lo ? 64 : 72, 4, YW, 2048); S.s0.mapM = lo ? 1 : 0;
                EpiMerge E{MG, GT};
                pg8::gemm_phase(lds, 2048, YW, 2048, S, E);
            } else if (EN(8) && sp == 8) {
                const bool lo = (l == DEPTH - 1);
                S.s0 = pg8::mksub(MG, W + WE_O, lo ? 64 : 72, 4, 1024, 1024); S.s0.mapM = lo ? 1 : 0;
                EpiResid E{H, modl, 5, rep_ ? 0.f : 1.0f, 0};
                pg8::gemm_phase(lds, 1024, 1024, 1024, S, E);
            }
        }
        if (ph + 1 < p.ph_hi) { if (ph == 0 && rep_ == 0) cg::this_grid().sync(); else xcd_barrier(xbar); }
      }
    }
}

extern "C" void kernel_launch(void* const* d_in, const int* in_sizes, int n_in, void* d_out, int out_size, void* d_ws, size_t ws_size, hipStream_t stream) {
    static int grid = 0;
    if (grid == 0) {
        if (ws_size < WS_NEED) { fprintf(stderr, "kernel_launch: workspace too small: need %zu have %zu\n", (size_t)WS_NEED, ws_size); grid = -1; return; }
        int dev = 0, cus = 0, per_cu = 0;
        hipGetDevice(&dev); hipDeviceGetAttribute(&cus, hipDeviceAttributeMultiprocessorCount, dev);
        if (hipFuncSetAttribute((const void*)fwd_kernel, hipFuncAttributeMaxDynamicSharedMemorySize, LDS_BYTES) != hipSuccess) { fprintf(stderr, "kernel_launch: hipFuncSetAttribute failed\n"); grid = -1; return; }
        if (hipOccupancyMaxActiveBlocksPerMultiprocessor(&per_cu, (const void*)fwd_kernel, NT, LDS_BYTES) != hipSuccess || per_cu < 1) { fprintf(stderr, "kernel_launch: occupancy query says %d\n", per_cu); per_cu = 1; }
        (void)hipGetLastError();
        grid = cus * per_cu;
        fprintf(stderr, "kernel_launch: grid %d (cus %d x %d), ws need %zu have %zu\n", grid, cus, per_cu, (size_t)WS_NEED, ws_size);
    }
    if (grid < 0) return;
    Params p{};
    const float** pp = (const float**)&p;
    for (int i = 0; i < 21; ++i) pp[i] = (const float*)d_in[i];
    p.out = (float*)d_out; p.ws = (unsigned char*)d_ws;
#if ONE_LAUNCH
    if (hipMemsetAsync((char*)d_ws + OFF_BAR, 0, BAR_BYTES, stream) != hipSuccess) { fprintf(stderr, "kernel_launch: memset of the barrier words failed\n"); return; }
    p.ph_lo = 0; p.ph_hi = NPH;
    void* args[] = {&p};
    hipError_t e = hipLaunchCooperativeKernel((const void*)fwd_kernel, dim3(grid), dim3(NT), args, LDS_BYTES, stream);
    if (e != hipSuccess) fprintf(stderr, "cooperative launch failed: %s (grid %d)\n", hipGetErrorString(e), grid);
#else
    for (int ph = 0; ph < NPH; ++ph) {
        p.ph_lo = ph; p.ph_hi = ph + 1;
        hipLaunchKernelGGL(fwd_kernel, dim3(grid), dim3(NT), LDS_BYTES, stream, p);
    }
#endif
}
```

```cpp
#include <hip/hip_runtime.h>
#include <hip/hip_cooperative_groups.h>
#include <cstdio>
namespace cg = cooperative_groups;

#define REPS(ph) 1
#ifndef ONE_LAUNCH
#define ONE_LAUNCH 1
#endif

#define LAS __attribute__((address_space(3)))
#define DI __device__ __forceinline__
typedef unsigned short bf16_t;
typedef short bf16x8 __attribute__((ext_vector_type(8)));
typedef float f32x4 __attribute__((ext_vector_type(4)));
typedef float f32x16 __attribute__((ext_vector_type(16)));
typedef unsigned u32x4 __attribute__((ext_vector_type(4)));
typedef unsigned u32x2 __attribute__((ext_vector_type(2)));

constexpr int DM = 1024, NB = 8, SEQ = 2048, CTX = 256, TPB = SEQ + CTX  , T = NB * TPB  ;
constexpr int DEPTH = 4, DFF = 2816, INW = 5792, NMOD = 9;
constexpr int NT = 512;
constexpr int YW = 2048;
constexpr int LDS_MAIN = 147456;
constexpr int LDS_BYTES = LDS_MAIN + 256;
constexpr float RMS_EPS = 1e-6f;

constexpr size_t al256(size_t x) { return (x + 255) & ~(size_t)255; }
constexpr size_t OFF_H = 0;
constexpr size_t OFF_AN = OFF_H + (size_t)T * DM * 4;
constexpr size_t OFF_R1 = OFF_AN + (size_t)T * DM * 2;
constexpr size_t OFF_QD = OFF_R1 + (size_t)T * 3072 * 2;
constexpr size_t OFF_KD = OFF_QD + (size_t)T * 512 * 2;
constexpr size_t OFF_VTD = OFF_KD + (size_t)T * 512 * 2;
constexpr size_t OFF_FT = OFF_VTD + (size_t)T * 512 * 2;
constexpr size_t OFF_FTC = OFF_FT + (size_t)NB * 512 * 4096 * 2;
constexpr size_t OFF_QM = OFF_FTC + (size_t)NB * 512 * 512 * 2;
constexpr size_t OFF_KM = OFF_QM + (size_t)T * 768 * 2;
constexpr size_t OFF_VTM = OFF_KM + (size_t)T * 768 * 2;
constexpr size_t OFF_Y = OFF_VTM + (size_t)T * 512 * 2;
constexpr size_t OFF_PQ = OFF_Y;
constexpr size_t OFF_CKV = OFF_PQ + (size_t)T * 512 * 2;
constexpr size_t OFF_RSQ = OFF_Y + (size_t)T * YW * 2;
constexpr size_t OFF_RSKV = OFF_RSQ + (size_t)T * 4;
constexpr size_t OFF_MOD = OFF_RSKV + (size_t)T * 4;
constexpr size_t OFF_ROPED = OFF_MOD + (size_t)DEPTH * 9 * 9216 * 4;
constexpr size_t OFF_ROPEM = OFF_ROPED + (size_t)2048 * 32 * 8;
constexpr size_t OFF_LAM = OFF_ROPEM + (size_t)2048 * 16 * 8;
constexpr size_t OFF_DFTL = OFF_LAM + 256;
constexpr size_t OFF_DFTC = OFF_DFTL + (size_t)2048 * 4096 * 2;
constexpr size_t OFF_W = OFF_DFTC + (size_t)256 * 512 * 2;
constexpr size_t WE_W1 = 0;
constexpr size_t WE_W2 = WE_W1 + (size_t)2 * 5632 * 1024;
constexpr size_t WE_IN = WE_W2 + (size_t)2 * 1024 * 2816;
constexpr size_t WE_V = WE_IN + (size_t)4864 * 1024;
constexpr size_t WE_F = WE_V + (size_t)512 * 1024;
constexpr size_t WE_UQ = WE_F + (size_t)1024 * 1024;
constexpr size_t WE_UK = WE_UQ + (size_t)768 * 384;
constexpr size_t WE_UV = WE_UK + (size_t)512 * 256;
constexpr size_t WE_B = WE_UV + (size_t)512 * 256;
constexpr size_t WE_O = WE_B + (size_t)1024 * 2048;
constexpr size_t WE_END = WE_O + (size_t)1024 * 1024;
constexpr size_t OFF_BAR = OFF_W + (size_t)DEPTH * WE_END * 2;
constexpr size_t BAR_BYTES = 3456 * 4;
constexpr size_t WS_NEED = OFF_BAR + BAR_BYTES;

struct Params {
    const float *x, *c, *ctx, *c_ctx, *ada_w, *ada_b, *norm_g, *ffn_w_in, *ffn_w_out, *w_in, *diff_lambda, *diff_subln_g, *mla_q_norm_g, *mla_w_uq,
        *mla_kv_norm_g, *mla_w_ukv, *w_bd, *w_bm, *w_bf, *w_out, *final_g;
    float* out; unsigned char* ws; int ph_lo, ph_hi;
};

DI unsigned pk2(float a, float b) {
    typedef float f2 __attribute__((ext_vector_type(2))); typedef __bf16 b2 __attribute__((ext_vector_type(2)));
    f2 v = {a, b}; b2 r = __builtin_convertvector(v, b2); return __builtin_bit_cast(unsigned, r);
}
DI float bflo(unsigned w) { return __uint_as_float(w << 16); }
DI float bfhi(unsigned w) { return __uint_as_float(w & 0xffff0000u); }
DI void store8(bf16_t* p, f32x4 a, f32x4 b) { u32x4 w = {pk2(a[0], a[1]), pk2(a[2], a[3]), pk2(b[0], b[1]), pk2(b[2], b[3])}; *(u32x4*)p = w; }
DI void load8(const bf16_t* p, f32x4& a, f32x4& b) { const u32x4 w = *(const u32x4*)p; a = (f32x4){bflo(w.x), bfhi(w.x), bflo(w.y), bfhi(w.y)}; b = (f32x4){bflo(w.z), bfhi(w.z), bflo(w.w), bfhi(w.w)}; }
DI float fast_exp2(float x) { return __builtin_amdgcn_exp2f(x); }
DI float sigmoidf_(float x) { return __builtin_amdgcn_rcpf(1.0f + fast_exp2(-1.44269504f * x)); }
DI float wave_sum(float v) { v += __shfl_xor(v, 32); v += __shfl_xor(v, 16); v += __shfl_xor(v, 8); v += __shfl_xor(v, 4); v += __shfl_xor(v, 2); v += __shfl_xor(v, 1); return v; }

DI void rope4(f32x4& v, const float* tab, float sg, int xm) {
    f32x4 q;
#pragma unroll
    for (int i = 0; i < 4; ++i) q[i] = __shfl_xor(v[i], xm);
    const f32x4 t0 = *(const f32x4*)tab, t1 = *(const f32x4*)(tab + 4);
    v[0] = v[0] * t0[0] + sg * q[0] * t0[1]; v[1] = v[1] * t0[2] + sg * q[1] * t0[3];
    v[2] = v[2] * t1[0] + sg * q[2] * t1[1]; v[3] = v[3] * t1[2] + sg * q[3] * t1[3];
}
DI void rope8(f32x4& v0, f32x4& v1, const float* tab, bool first, int xm) {
    const float sg = first ? -1.f : 1.f;
    rope4(v0, tab, sg, xm); asm volatile("" ::: "memory");
    rope4(v1, tab + 8, sg, xm); asm volatile("" ::: "memory");
}

namespace pg8 {
constexpr int BM = 256, BK = 64, HALF = 128, HTB = HALF * BK * 2, STAGE_BYTES = 8 * HTB;
DI int lds_byte(int r, int c) { const int st = (r >> 4) * 2 + (c >> 5), rr = r & 15, cc = c & 31, ob = rr * 64 + cc * 2; return st * 1024 + (ob ^ (((ob >> 9) & 1) << 5)); }
DI void stage_rc(int b, int& R, int& C) { const int st = b / 1024, sb = b % 1024, swz = sb ^ (((sb >> 9) & 1) << 5); R = (st >> 1) * 16 + swz / 64; C = (st & 1) * 32 + (swz % 64) / 2; }
DI int perm32(int rho) { const int n = rho >> 4, i = rho & 15; return 8 * (i >> 2) + 4 * n + (i & 3); }

struct Unit { const char* a; const char* b; int pm, pn, s, z; };

struct Sub { const char* A; const char* B; int nM, nN, mmod, mode, mapM, mapN, ksplit; size_t tsa, tsb, zb, kbytes; };
struct Sched {
    Sub s0, s1, s2; int ns, G, c, rep; size_t za, zb;
    static DI int panel(int map, int p) { return map == 1 ? (p >> 3) * 9 + 1 + (p & 7) : map == 2 ? p * 9 : p; }
    DI bool pick(const Sub& S, int sid, long& L, int z, Unit& u) const {
        const long cnt = (long)S.nM * S.nN * S.ksplit;
        if (L >= cnt) { L -= cnt; return false; }
        const int w = (int)L / S.ksplit, zk = (int)L - w * S.ksplit, nig = 8 * S.nN, gid = w / nig, fm = gid * 8, gsz = (S.nM - fm) < 8 ? (S.nM - fm) : 8;
        u.pm = panel(S.mapM, fm + ((w % nig) % gsz)); u.pn = panel(S.mapN, (w % nig) / gsz); u.s = sid; u.z = z + zk;
        if (S.mode == 1) { const int q = u.pm >> 3; u.a = S.A + (size_t)(u.pm & 7) * S.tsa + (size_t)(q & 1) * 4096; u.b = S.B + (size_t)u.pn * S.tsb + (size_t)(q >> 1) * S.zb + (size_t)(q & 1) * 4096; }
        else {
        u.a = S.A + (size_t)(u.pm % S.mmod) * S.tsa + (size_t)z * za;
        u.b = S.B + (size_t)u.pn * S.tsb + (size_t)(u.pm / S.mmod) * S.zb + (size_t)z * zb; }
        u.a += (size_t)zk * S.kbytes; u.b += (size_t)zk * S.kbytes;
        return true;
    }
    DI bool next(int i, Unit& u) const {
        const int j = i / rep, z = i - j * rep;
        long L = (long)j * G + c;
        if (pick(s0, 0, L, z, u)) return true;
        if (ns > 1 && pick(s1, 1, L, z, u)) return true;
        if (ns > 2 && pick(s2, 2, L, z, u)) return true;
        return false;
    }
};
DI Sub mksub(const void* A, const void* B, int nM, int nN, int lda, int ldb) { Sub s; s.A = (const char*)A; s.B = (const char*)B; s.nM = nM; s.nN = nN; s.mmod = 1 << 30; s.mode = 0; s.mapM = 0; s.mapN = 0; s.ksplit = 1; s.kbytes = 0; s.tsa = (size_t)256 * lda * 2; s.tsb = (size_t)256 * ldb * 2; s.zb = 0; return s; }

template <class Epi>
DI void gemm_phase(LAS unsigned char* lds, const int K, const int lda, const int ldb, const Sched& S, const Epi& E) {
    int tid = threadIdx.x; asm volatile("" : "+v"(tid));
    const int wid = __builtin_amdgcn_readfirstlane(tid >> 6), lane = tid & 63, wr = wid >> 2, wc = wid & 3, fr = lane & 15, fq = lane >> 4;
    const int nt = K / BK;
    unsigned voffA[2], voffB[2];
#pragma unroll
    for (int i = 0; i < 2; ++i) { int R, C; stage_rc(tid * 16 + i * 8192, R, C); const int Rb = Epi::PERM ? ((R & ~31) + perm32(R & 31)) : R;
        voffA[i] = (unsigned)(R * lda + C) * 2u; voffB[i] = (unsigned)(Rb * ldb + C) * 2u; }
    const size_t kstep = (size_t)(BK * 2);
    const size_t hsA = (size_t)HALF * lda * 2, hsB = (size_t)HALF * ldb * 2;
    const unsigned ldsw = (unsigned)wid * 1024u;
    const int aoff = lds_byte(wr * 64 + fr, fq * 8), boff = lds_byte(wc * 32 + fr, fq * 8);
#define PG8_SA(b, h) (((b) * 2 + (h)) * HTB)
#define PG8_SB(b, h) ((4 + (b) * 2 + (h)) * HTB)
#define PG8_STAGE(bufoff, gbase, voff) do { _Pragma("unroll") for (int _i = 0; _i < 2; ++_i) \
        __builtin_amdgcn_global_load_lds((const unsigned*)((const char*)(gbase) + (voff)[_i]), (LAS unsigned*)(lds + (bufoff) + ldsw + _i * 8192), 16, 0, 0); } while (0)
#define PG8_LDA(dst, b, h) do { _Pragma("unroll") for (int m = 0; m < 4; ++m) _Pragma("unroll") for (int k = 0; k < 2; ++k) dst[m][k] = *(const LAS bf16x8*)(lds + PG8_SA(b, h) + aoff + m * 2048 + k * 1024); } while (0)
#define PG8_LDB(dst, b, h) do { _Pragma("unroll") for (int n = 0; n < 2; ++n) _Pragma("unroll") for (int k = 0; k < 2; ++k) dst[n][k] = *(const LAS bf16x8*)(lds + PG8_SB(b, h) + boff + n * 2048 + k * 1024); } while (0)
#define PG8_MMA(ai, bj, At, Bt) do { __builtin_amdgcn_s_setprio(1); _Pragma("unroll") for (int m = 0; m < 4; ++m) _Pragma("unroll") for (int n = 0; n < 2; ++n) _Pragma("unroll") for (int k = 0; k < 2; ++k) \
        acc[ai][bj][m][n] = __builtin_amdgcn_mfma_f32_16x16x32_bf16(Bt[n][k], At[m][k], acc[ai][bj][m][n], 0, 0, 0); __builtin_amdgcn_s_setprio(0); } while (0)
#define PG8_WAIT_V(n) asm volatile("s_waitcnt vmcnt(" #n ")" ::: "memory")
#define PG8_WAIT_L(n) asm volatile("s_waitcnt lgkmcnt(" #n ")" ::: "memory")
#define PG8_BAR __builtin_amdgcn_s_barrier()
#define PG8_SCHED __builtin_amdgcn_sched_barrier(0)
    Unit cur, nxt; int ui = 0;
    if (!S.next(0, cur)) return;
    f32x4 acc[2][2][4][2];
#pragma unroll
    for (int a = 0; a < 2; ++a)
#pragma unroll
        for (int b = 0; b < 2; ++b)
#pragma unroll
            for (int m = 0; m < 4; ++m)
#pragma unroll
                for (int n = 0; n < 2; ++n) acc[a][b][m][n] = (f32x4){0.f, 0.f, 0.f, 0.f};
    bf16x8 At[4][2], B0[2][2], B1[2][2];
    const char* cA = cur.a; const char* cB = cur.b;
    PG8_STAGE(PG8_SB(0, 0), cB, voffB); PG8_STAGE(PG8_SA(0, 0), cA, voffA); PG8_STAGE(PG8_SB(0, 1), cB + hsB, voffB); PG8_STAGE(PG8_SA(0, 1), cA + hsA, voffA);
    if (wr == 1) PG8_BAR;
    PG8_WAIT_V(4); PG8_BAR;
    PG8_STAGE(PG8_SB(1, 0), cB + kstep, voffB); PG8_STAGE(PG8_SA(1, 0), cA + kstep, voffA); PG8_STAGE(PG8_SB(1, 1), cB + hsB + kstep, voffB);
    PG8_WAIT_V(6); PG8_BAR;
    for (;;) {
        const bool has_next = S.next(ui + 1, nxt);
        const char* nA = has_next ? nxt.a : cA; const char* nB = has_next ? nxt.b : cB;
        for (int t = 0; t < nt; t += 2) {
            const bool last = (t == nt - 2);
            if constexpr (Epi::MID) { if (t == 8 || t == 16) { int fr2 = fr, fq2 = fq; asm volatile("" : "+v"(fr2), "+v"(fq2)); E.mid(acc, cur, t == 16 ? 1 : 0, wr, wc, fr2, fq2); } }
            const char* a1 = cA + (size_t)(t + 1) * kstep;
            const char* a2 = last ? nA : cA + (size_t)(t + 2) * kstep; const char* b2 = last ? nB : cB + (size_t)(t + 2) * kstep;
            const char* a3 = a2 + kstep; const char* b3 = b2 + kstep;
            PG8_LDB(B0, 0, 0); PG8_SCHED; PG8_LDA(At, 0, 0); PG8_STAGE(PG8_SA(1, 1), a1 + hsA, voffA);
            PG8_WAIT_L(8); PG8_BAR; PG8_WAIT_L(0); PG8_MMA(0, 0, At, B0); PG8_BAR; PG8_SCHED;
            PG8_LDB(B1, 0, 1); PG8_STAGE(PG8_SB(0, 0), b2, voffB);
            PG8_BAR; PG8_WAIT_L(0); PG8_MMA(0, 1, At, B1); PG8_BAR;
            PG8_LDA(At, 0, 1); PG8_STAGE(PG8_SA(0, 0), a2, voffA);
            PG8_BAR; PG8_WAIT_L(0); PG8_MMA(1, 0, At, B0); PG8_BAR; PG8_SCHED;
            PG8_STAGE(PG8_SB(0, 1), b2 + hsB, voffB);
            PG8_WAIT_V(6); PG8_BAR; PG8_MMA(1, 1, At, B1); PG8_BAR;
            PG8_LDB(B0, 1, 0); PG8_SCHED; PG8_LDA(At, 1, 0); PG8_STAGE(PG8_SA(0, 1), a2 + hsA, voffA);
            PG8_WAIT_L(8); PG8_BAR; PG8_WAIT_L(0); PG8_MMA(0, 0, At, B0); PG8_BAR; PG8_SCHED;
            PG8_LDB(B1, 1, 1); PG8_STAGE(PG8_SB(1, 0), b3, voffB);
            PG8_BAR; PG8_WAIT_L(0); PG8_MMA(0, 1, At, B1); PG8_BAR;
            PG8_LDA(At, 1, 1); PG8_STAGE(PG8_SA(1, 0), a3, voffA);
            PG8_BAR; PG8_WAIT_L(0); PG8_MMA(1, 0, At, B0); PG8_BAR; PG8_SCHED;
            PG8_STAGE(PG8_SB(1, 1), b3 + hsB, voffB);
            PG8_WAIT_V(6); PG8_BAR; PG8_MMA(1, 1, At, B1); PG8_BAR;
        }
        { int fr2 = fr, fq2 = fq; asm volatile("" : "+v"(fr2), "+v"(fq2));
          E(acc, cur, wr, wc, fr2, fq2); }
        if (!has_next) break;
#pragma unroll
        for (int a = 0; a < 2; ++a)
#pragma unroll
            for (int b = 0; b < 2; ++b)
#pragma unroll
                for (int m = 0; m < 4; ++m)
#pragma unroll
                    for (int n = 0; n < 2; ++n) acc[a][b][m][n] = (f32x4){0.f, 0.f, 0.f, 0.f};
        cur = nxt; cA = nA; cB = nB; ++ui;
    }
    PG8_WAIT_V(0);
    if (wr == 0) PG8_BAR;
    PG8_BAR;
#undef PG8_SA
#undef PG8_SB
#undef PG8_STAGE
#undef PG8_LDA
#undef PG8_LDB
#undef PG8_MMA
#undef PG8_WAIT_V
#undef PG8_WAIT_L
#undef PG8_BAR
#undef PG8_SCHED
}
}
using pg8::Unit;
typedef const f32x4 (&AccRef)[2][2][4][2];

struct EpiSwiglu {
    static constexpr bool PERM = true, MID = false;
    bf16_t* ACT;
    DI void operator()(AccRef acc, const Unit& u, int wr, int wc, int fr, int fq) const {
        const int row0 = u.pm * 256 + wr * 64 + fr, col0 = u.pn * 128 + wc * 32 + 8 * fq;
#pragma unroll
        for (int ai = 0; ai < 2; ++ai)
#pragma unroll
            for (int m = 0; m < 4; ++m) {
                f32x4 o[2];
#pragma unroll
                for (int n = 0; n < 2; ++n)
#pragma unroll
                    for (int i = 0; i < 4; ++i) { const float g = acc[ai][0][m][n][i]; o[n][i] = g * sigmoidf_(g) * acc[ai][1][m][n][i]; }
                store8(ACT + (size_t)(row0 + ai * 128 + m * 16) * DFF + col0, o[0], o[1]);
            }
    }
};
struct EpiResid {
    static constexpr bool PERM = false, MID = false;
    float* H; const float* modl; int gidx; float fac; int atomic;
    DI void operator()(AccRef acc, const Unit& u, int wr, int wc, int fr, int fq) const {
        const int mrow = (u.pm % 9 == 0) ? 8 : u.pm / 9;
        const float* gate = modl + (size_t)mrow * 9216 + gidx * 1024;
        const int row0 = u.pm * 256 + wr * 64 + fr, col0 = u.pn * 256 + wc * 32 + 4 * fq;
        f32x4 gv[2][2];
#pragma unroll
        for (int bj = 0; bj < 2; ++bj)
#pragma unroll
            for (int n = 0; n < 2; ++n) gv[bj][n] = *(const f32x4*)(gate + col0 + bj * 128 + n * 16) * fac;
#pragma unroll
        for (int ai = 0; ai < 2; ++ai)
#pragma unroll
            for (int m = 0; m < 4; ++m) {
                float* rowp = H + (size_t)(row0 + ai * 128 + m * 16) * DM + col0;
#pragma unroll
                for (int bj = 0; bj < 2; ++bj)
#pragma unroll
                    for (int n = 0; n < 2; ++n) { f32x4* p = (f32x4*)(rowp + bj * 128 + n * 16); const f32x4 v = gv[bj][n] * acc[ai][bj][m][n];
                        if (atomic) { unsafeAtomicAdd((float*)p, v[0]); unsafeAtomicAdd((float*)p + 1, v[1]); unsafeAtomicAdd((float*)p + 2, v[2]); unsafeAtomicAdd((float*)p + 3, v[3]); }
                        else *p = *p + v; }
            }
    }
};
struct EpiIn {
    static constexpr bool PERM = true, MID = false;
    bf16_t *QD, *KD, *PQ, *CKV, *G, *KM, *VTD, *FT, *FTC; float *rsq, *rskv; const float *RD, *RM;
    DI void operator()(AccRef acc, const Unit& u, int wr, int wc, int fr, int fq) const {
        if (u.s == 0) {
            const int pn = u.pn, tt = u.pm % 9; const bool lat = tt != 0;
            const int rl0 = wr * 64 + fr;
            if (pn < 4) {
                bf16_t* dst = (pn < 2) ? QD : KD;
                const int colb = (pn & 1) * 256 + wc * 32 + 8 * fq, sel = wc & 1; const bool first = (fq >> 1) == 0;
#pragma unroll
                for (int ai = 0; ai < 2; ++ai)
#pragma unroll
                    for (int m = 0; m < 4; ++m) {
                        const int rl = rl0 + ai * 128 + m * 16; const size_t row = (size_t)u.pm * 256 + rl; const int pos = (tt - 1) * 256 + rl;
#pragma unroll
                        for (int bj = 0; bj < 2; ++bj) {
                            f32x4 v0 = acc[ai][bj][m][0], v1 = acc[ai][bj][m][1];
                            if (lat) rope8(v0, v1, RD + ((size_t)pos * 32 + sel * 16 + 8 * (fq & 1)) * 2, first, 32);
                            store8(dst + row * 512 + colb + bj * 128, v0, v1);
                            asm volatile("" ::: "memory");
                        }
                    }
            } else if (pn < 6) {
#pragma unroll
                for (int ai = 0; ai < 2; ++ai)
#pragma unroll
                    for (int m = 0; m < 4; ++m) {
                        const int rl = rl0 + ai * 128 + m * 16; const size_t row = (size_t)u.pm * 256 + rl; const int pos = (tt - 1) * 256 + rl;
#pragma unroll
                        for (int bj = 0; bj < 2; ++bj) {
                            f32x4 v0 = acc[ai][bj][m][0], v1 = acc[ai][bj][m][1];
                            const int c = (pn - 4) * 256 + bj * 128 + wc * 32;
                            if (c < 384) {
                                float ss = v0[0] * v0[0] + v0[1] * v0[1] + v0[2] * v0[2] + v0[3] * v0[3] + v1[0] * v1[0] + v1[1] * v1[1] + v1[2] * v1[2] + v1[3] * v1[3];
                                ss += __shfl_xor(ss, 16); ss += __shfl_xor(ss, 32);
                                if (fq == 0) atomicAdd(rsq + row, ss);
                                store8(PQ + row * 512 + c + 8 * fq, v0, v1);
                            } else if (c == 384) {
                                if (lat) rope8(v0, v1, RM + ((size_t)pos * 16 + (fq >> 1) * 8) * 2, (fq & 1) == 0, 16);
#pragma unroll
                                for (int h = 0; h < 8; ++h) store8(KM + row * 768 + h * 96 + 64 + 8 * fq, v0, v1);
                            }
                            asm volatile("" ::: "memory");
                        }
                    }
            } else if (pn == 6) {
#pragma unroll
                for (int ai = 0; ai < 2; ++ai)
#pragma unroll
                    for (int m = 0; m < 4; ++m) {
                        const size_t row = (size_t)u.pm * 256 + rl0 + ai * 128 + m * 16;
#pragma unroll
                        for (int bj = 0; bj < 2; ++bj) {
                            const f32x4 v0 = acc[ai][bj][m][0], v1 = acc[ai][bj][m][1];
                            float ss = v0[0] * v0[0] + v0[1] * v0[1] + v0[2] * v0[2] + v0[3] * v0[3] + v1[0] * v1[0] + v1[1] * v1[1] + v1[2] * v1[2] + v1[3] * v1[3];
                            ss += __shfl_xor(ss, 16); ss += __shfl_xor(ss, 32);
                            if (fq == 0) atomicAdd(rskv + row, ss);
                            store8(CKV + row * 256 + bj * 128 + wc * 32 + 8 * fq, v0, v1);
                            asm volatile("" ::: "memory");
                        }
                    }
            } else {
                const int colb = (pn - 7) * 256 + wc * 32 + 8 * fq;
#pragma unroll
                for (int ai = 0; ai < 2; ++ai)
#pragma unroll
                    for (int m = 0; m < 4; ++m) {
                        const size_t row = (size_t)u.pm * 256 + rl0 + ai * 128 + m * 16;
#pragma unroll
                        for (int bj = 0; bj < 2; ++bj) {
                            f32x4 v0 = acc[ai][bj][m][0], v1 = acc[ai][bj][m][1];
#pragma unroll
                            for (int i = 0; i < 4; ++i) { v0[i] = sigmoidf_(v0[i]); v1[i] = sigmoidf_(v1[i]); }
                            store8(G + row * 3072 + colb + bj * 128, v0, v1);
                        }
                    }
            }
        } else {
            const int b = u.pn / 9, tt = u.pn % 9, cl = wc * 32 + 8 * fq;
#pragma unroll
            for (int ai = 0; ai < 2; ++ai)
#pragma unroll
                for (int m = 0; m < 4; ++m) {
                    const int r = u.pm * 256 + ai * 128 + wr * 64 + m * 16 + fr;
                    bf16_t* dst;
                    if (u.s == 1) dst = VTD + ((size_t)(b * 4 + (r >> 7)) * 128 + (r & 127)) * TPB + tt * 256;
                    else {
                        const int g = r >> 8, part = (r >> 7) & 1, mm = r & 127;
                        dst = (tt == 0) ? FTC + ((size_t)(b * 512 + g * 128 + mm) * 512 + part * 256)
                                        : FT + ((size_t)(b * 512 + g * 128 + mm) * 4096 + part * 2048 + (tt - 1) * 256);
                    }
#pragma unroll
                    for (int bj = 0; bj < 2; ++bj) store8(dst + bj * 128 + cl, acc[ai][bj][m][0], acc[ai][bj][m][1]);
                }
        }
    }
};
struct EpiUp {
    static constexpr bool PERM = true, MID = false;
    bf16_t *QM, *KM, *VTM; const float *rsq, *rskv, *RM; int mode;
    DI void operator()(AccRef acc, const Unit& u, int wr, int wc, int fr, int fq) const {
        if (mode == 0) {
            const int tt = u.pm % 9; const bool lat = tt != 0; const int rl0 = wr * 64 + fr;
#pragma unroll
            for (int ai = 0; ai < 2; ++ai)
#pragma unroll
                for (int m = 0; m < 4; ++m) {
                    const int rl = rl0 + ai * 128 + m * 16; const size_t row = (size_t)u.pm * 256 + rl; const int pos = (tt - 1) * 256 + rl;
                    const float rs = __builtin_amdgcn_rsqf(rsq[row] * (1.0f / 384.0f) + RMS_EPS);
#pragma unroll
                    for (int bj = 0; bj < 2; ++bj) {
                        const int c = u.pn * 256 + bj * 128 + wc * 32;
                        f32x4 v0 = acc[ai][bj][m][0] * rs, v1 = acc[ai][bj][m][1] * rs;
                        if (((c >> 5) % 3) == 2 && lat) rope8(v0, v1, RM + ((size_t)pos * 16 + (fq >> 1) * 8) * 2, (fq & 1) == 0, 16);
                        store8(QM + row * 768 + c + 8 * fq, v0, v1);
                    }
                    asm volatile("" ::: "memory");
                }
        } else if (u.s == 0) {
#pragma unroll
            for (int ai = 0; ai < 2; ++ai)
#pragma unroll
                for (int m = 0; m < 4; ++m) {
                    const size_t row = (size_t)u.pm * 256 + wr * 64 + fr + ai * 128 + m * 16;
                    const float rs = __builtin_amdgcn_rsqf(rskv[row] * (1.0f / 256.0f) + RMS_EPS);
#pragma unroll
                    for (int bj = 0; bj < 2; ++bj) {
                        const int c = u.pn * 256 + bj * 128 + wc * 32 + 8 * fq;
                        store8(KM + row * 768 + (c >> 6) * 96 + (c & 63), acc[ai][bj][m][0] * rs, acc[ai][bj][m][1] * rs);
                    }
                    asm volatile("" ::: "memory");
                }
        } else {
            const int b = u.pn / 9, tt = u.pn % 9, cl = wc * 32 + 8 * fq;
#pragma unroll
            for (int bj = 0; bj < 2; ++bj) {
                f32x4 rs[2];
#pragma unroll
                for (int n = 0; n < 2; ++n) {
                    const f32x4 q = *(const f32x4*)(rskv + (size_t)u.pn * 256 + bj * 128 + cl + 4 * n);
#pragma unroll
                    for (int i = 0; i < 4; ++i) rs[n][i] = __builtin_amdgcn_rsqf(q[i] * (1.0f / 256.0f) + RMS_EPS);
                }
#pragma unroll
                for (int ai = 0; ai < 2; ++ai)
#pragma unroll
                    for (int m = 0; m < 4; ++m) {
                        const int r = u.pm * 256 + ai * 128 + wr * 64 + m * 16 + fr;
                        bf16_t* dst = VTM + ((size_t)(b * 8 + (r >> 6)) * 64 + (r & 63)) * TPB + tt * 256;
                        store8(dst + bj * 128 + cl, acc[ai][bj][m][0] * rs[0], acc[ai][bj][m][1] * rs[1]);
                    }
                asm volatile("" ::: "memory");
            }
        }
    }
};
struct EpiF2 {
    static constexpr bool PERM = true, MID = false;
    bf16_t* Y; int ctx;
    DI void operator()(AccRef acc, const Unit& u, int wr, int wc, int fr, int fq) const {
        const int q = u.pm >> 3;
        const size_t rowb = ctx ? (size_t)u.pm * TPB : (size_t)(q >> 1) * TPB + 256 + (u.pm & 7) * 256;
        const int colb = 1024 + (ctx ? 0 : (q & 1) * 512) + u.pn * 256 + wc * 32 + 8 * fq;
#pragma unroll
        for (int ai = 0; ai < 2; ++ai)
#pragma unroll
            for (int m = 0; m < 4; ++m) {
                const size_t row = rowb + wr * 64 + fr + ai * 128 + m * 16;
#pragma unroll
                for (int bj = 0; bj < 2; ++bj) {
                    store8(Y + row * YW + colb + bj * 128, acc[ai][bj][m][0], acc[ai][bj][m][1]);
                    if (ctx) *(u32x4*)(Y + row * YW + colb + bj * 128 + 512) = (u32x4){0u, 0u, 0u, 0u};
                }
            }
    }
};
struct EpiMerge {
    static constexpr bool PERM = true, MID = true;
    bf16_t* MG; const bf16_t* G;
    DI void mid(f32x4 (&acc)[2][2][4][2], const Unit& u, int which, int wr, int wc, int fr, int fq) const {
#pragma unroll
        for (int ai = 0; ai < 2; ++ai)
#pragma unroll
            for (int m = 0; m < 4; ++m) {
                const size_t row = (size_t)u.pm * 256 + wr * 64 + fr + ai * 128 + m * 16;
#pragma unroll
                for (int bj = 0; bj < 2; ++bj) {
                    const int c = u.pn * 256 + bj * 128 + wc * 32 + 8 * fq;
                    f32x4 a0, a1, b0, b1; load8(G + row * 3072 + which * 1024 + c, a0, a1); load8(G + row * 3072 + (which + 1) * 1024 + c, b0, b1);
#pragma unroll
                    for (int i = 0; i < 4; ++i) { acc[ai][bj][m][0][i] *= a0[i] * __builtin_amdgcn_rcpf(b0[i]); acc[ai][bj][m][1][i] *= a1[i] * __builtin_amdgcn_rcpf(b1[i]); }
                }
                asm volatile("" ::: "memory");
            }
    }
    DI void operator()(AccRef acc, const Unit& u, int wr, int wc, int fr, int fq) const {
#pragma unroll
        for (int ai = 0; ai < 2; ++ai)
#pragma unroll
            for (int m = 0; m < 4; ++m) {
                const size_t row = (size_t)u.pm * 256 + wr * 64 + fr + ai * 128 + m * 16;
#pragma unroll
                for (int bj = 0; bj < 2; ++bj) {
                    const int c = u.pn * 256 + bj * 128 + wc * 32 + 8 * fq;
                    f32x4 g0, g1; load8(G + row * 3072 + 2048 + c, g0, g1);
                    store8(MG + row * 1024 + c, g0 * acc[ai][bj][m][0], g1 * acc[ai][bj][m][1]);
                }
            }
    }
};

#define MFMA32(a, b, c) __builtin_amdgcn_mfma_f32_32x32x16_bf16((a), (b), (c), 0, 0, 0)
template <int D, int DV, bool DIFF>
DI void attn_item(LAS unsigned char* lds, const bf16_t* Qb, int ldq, const bf16_t* Kb, int ldk, const bf16_t* VT, int nkeys, int nq,
                  bf16_t* Yb, float lam, float outfac, const float* subg) {
    constexpr int KROW = (DIFF ? 256 : 192) + 16, VROW = 144, KBYTES = 64 * KROW, VBYTES = DV * VROW, STAGE = KBYTES + VBYTES;
    constexpr int KCH = DIFF ? 16 : 12, NKC = 64 * KCH, NVC = DV * 8, NKK = D / 16, NDVB = DV / 32;
    int tid = threadIdx.x; asm volatile("" : "+v"(tid));
    const int wave = __builtin_amdgcn_readfirstlane(tid >> 6), lane = tid & 63, l32 = lane & 31, half = lane >> 5;
    const float cs = (DIFF ? 0.125f : 0.10206207261596575f) * 1.4426950408889634f;
    const bool active = DIFF ? true : (wave * 64 < nq);
    bf16x8 qf[2][DIFF ? 1 : NKK];
    const LAS unsigned char* qlds = lds + 2 * STAGE + (wave * 32 + l32) * KROW + half * 16;
    if (DIFF) {
#pragma unroll
        for (int i = 0; i < 8; ++i) { const int ch = tid + i * NT, r = ch >> 4, cc = ch & 15;
            *(LAS u32x4*)(lds + 2 * STAGE + r * KROW + cc * 16) = *(const u32x4*)(Qb + (size_t)r * ldq + cc * 8); }
    } else {
#pragma unroll
        for (int s = 0; s < 2; ++s)
#pragma unroll
            for (int kk = 0; kk < NKK; ++kk) {
                const int qr = wave * 64 + s * 32 + l32, qc = kk * 16 + half * 8;
                qf[s][DIFF ? 0 : kk] = active ? *(const bf16x8*)(Qb + (size_t)qr * ldq + qc) : (bf16x8){0, 0, 0, 0, 0, 0, 0, 0};
            }
    }
    f32x16 O[2][NDVB];
#pragma unroll
    for (int s = 0; s < 2; ++s)
#pragma unroll
        for (int d = 0; d < NDVB; ++d)
#pragma unroll
            for (int i = 0; i < 16; ++i) O[s][d][i] = 0.f;
    float mrun[2] = {-1e30f, -1e30f}, lsum[2] = {0.f, 0.f};
    const int nt = nkeys / 64;
    u32x4 kr[2], vr[2];
    const int kc0 = tid, kc1 = tid + NT;
    const bool k1ok = kc1 < NKC, v1ok = (tid + NT) < NVC;
    const int krow0 = kc0 / KCH, kcc0 = kc0 % KCH, krow1 = kc1 / KCH, kcc1 = kc1 % KCH;
    const int vrow0 = tid >> 3, vcc0 = tid & 7, vrow1 = (tid + NT) >> 3;
#define ATT_LOAD(t) do { const int key0 = (t) * 64; \
        kr[0] = *(const u32x4*)(Kb + (size_t)(key0 + krow0) * ldk + kcc0 * 8); \
        if (k1ok) kr[1] = *(const u32x4*)(Kb + (size_t)(key0 + krow1) * ldk + kcc1 * 8); \
        vr[0] = *(const u32x4*)(VT + (size_t)vrow0 * TPB + key0 + vcc0 * 8); \
        if (v1ok) vr[1] = *(const u32x4*)(VT + (size_t)vrow1 * TPB + key0 + vcc0 * 8); } while (0)
#define ATT_WRITE(st) do { LAS unsigned char* sb = lds + (st) * STAGE; \
        *(LAS u32x4*)(sb + krow0 * KROW + kcc0 * 16) = kr[0]; \
        if (k1ok) *(LAS u32x4*)(sb + krow1 * KROW + kcc1 * 16) = kr[1]; \
        *(LAS u32x4*)(sb + KBYTES + vrow0 * VROW + vcc0 * 16) = vr[0]; \
        if (v1ok) *(LAS u32x4*)(sb + KBYTES + vrow1 * VROW + vcc0 * 16) = vr[1]; } while (0)
    ATT_LOAD(0); ATT_WRITE(0); __syncthreads();
    for (int t = 0; t < nt; ++t) {
        if (t + 1 < nt) ATT_LOAD(t + 1);
        if (active) {
            const LAS unsigned char* sb = lds + (t & 1) * STAGE;
#pragma unroll
            for (int kb = 0; kb < 2; ++kb) {
                bf16x8 P[2][2];
                f32x16 S[2];
                if (!DIFF) {
#pragma unroll
                    for (int s = 0; s < 2; ++s)
#pragma unroll
                        for (int i = 0; i < 16; ++i) S[s][i] = 0.f;
#pragma unroll
                    for (int kk = 0; kk < NKK; ++kk) {
                        const bf16x8 kf = *(const LAS bf16x8*)(sb + (kb * 32 + l32) * KROW + (kk * 16 + half * 8) * 2);
                        S[0] = MFMA32(kf, qf[0][DIFF ? 0 : kk], S[0]); S[1] = MFMA32(kf, qf[1][DIFF ? 0 : kk], S[1]);
                    }
                }
#pragma unroll
                for (int s = 0; s < 2; ++s) {
                    if (DIFF) {
#pragma unroll
                        for (int i = 0; i < 16; ++i) S[s][i] = 0.f;
#pragma unroll
                        for (int kk = 0; kk < NKK; ++kk) {
                            const bf16x8 kf = *(const LAS bf16x8*)(sb + (kb * 32 + l32) * KROW + (s * 64 + kk * 16 + half * 8) * 2);
                            const bf16x8 qq = *(const LAS bf16x8*)(qlds + (s * 64 + kk * 16) * 2);
                            S[s] = MFMA32(kf, qq, S[s]);
                        }
                    }
                    float mx = S[s][0];
#pragma unroll
                    for (int i = 1; i < 16; ++i) mx = fmaxf(mx, S[s][i]);
                    mx = fmaxf(mx, __shfl_xor(mx, 32));
                    const float mt2 = mx * cs;
                    if (__builtin_amdgcn_ballot_w64(mt2 > mrun[s] + 8.0f) != 0ull) {
                        const float mnew = fmaxf(mrun[s], mt2), alpha = fast_exp2(mrun[s] - mnew);
                        lsum[s] *= alpha;
#pragma unroll
                        for (int d = 0; d < NDVB; ++d)
#pragma unroll
                            for (int i = 0; i < 16; ++i) O[s][d][i] *= alpha;
                        mrun[s] = mnew;
                    }
                    float ls = 0.f;
#pragma unroll
                    for (int i = 0; i < 16; ++i) { S[s][i] = fast_exp2(S[s][i] * cs - mrun[s]); ls += S[s][i]; }
                    lsum[s] += ls;
#pragma unroll
                    for (int k2 = 0; k2 < 2; ++k2) {
                        u32x4 w = {pk2(S[s][8 * k2], S[s][8 * k2 + 1]), pk2(S[s][8 * k2 + 2], S[s][8 * k2 + 3]), pk2(S[s][8 * k2 + 4], S[s][8 * k2 + 5]), pk2(S[s][8 * k2 + 6], S[s][8 * k2 + 7])};
                        P[s][k2] = __builtin_bit_cast(bf16x8, w);
                    }
                    if (DIFF) asm volatile("" ::: "memory");
                }
#pragma unroll
                for (int d = 0; d < NDVB; ++d)
#pragma unroll
                    for (int k2 = 0; k2 < 2; ++k2) {
                        const LAS unsigned char* va = sb + KBYTES + (d * 32 + l32) * VROW + (kb * 32 + k2 * 16 + half * 4) * 2;
                        const u32x2 lo = *(const LAS u32x2*)va, hi = *(const LAS u32x2*)(va + 16);
                        const u32x4 w = {lo.x, lo.y, hi.x, hi.y};
                        const bf16x8 vf = __builtin_bit_cast(bf16x8, w);
                        O[0][d] = MFMA32(vf, P[0][k2], O[0][d]); O[1][d] = MFMA32(vf, P[1][k2], O[1][d]);
                        if (DIFF) asm volatile("" ::: "memory");
                    }
            }
        }
        if (t + 1 < nt) ATT_WRITE((t + 1) & 1);
        __syncthreads();
    }
#undef ATT_LOAD
#undef ATT_WRITE
    if (!active) return;
    int l32e = l32, halfe = half; asm volatile("" : "+v"(l32e), "+v"(halfe));
    float inv[2];
#pragma unroll
    for (int s = 0; s < 2; ++s) { const float l = lsum[s] + __shfl_xor(lsum[s], 32); inv[s] = 1.0f / l; }
    if (DIFF) {
        float ss = 0.f;
#pragma unroll
        for (int d = 0; d < NDVB; ++d)
#pragma unroll
            for (int i = 0; i < 16; ++i) { const float o = O[0][d][i] * inv[0] - lam * (O[1][d][i] * inv[1]); O[0][d][i] = o; ss += o * o; }
        ss += __shfl_xor(ss, 32);
        const float rs = __builtin_amdgcn_rsqf(ss * (1.0f / 128.0f) + RMS_EPS) * outfac;
        bf16_t* yr = Yb + (size_t)(wave * 32 + l32e) * YW;
#pragma unroll
        for (int d = 0; d < NDVB; ++d)
#pragma unroll
            for (int g4 = 0; g4 < 4; ++g4) {
                const int dv = d * 32 + g4 * 8 + halfe * 4;
                const f32x4 gg = *(const f32x4*)(subg + dv);
                u32x2 w = {pk2(O[0][d][4 * g4] * rs * gg[0], O[0][d][4 * g4 + 1] * rs * gg[1]), pk2(O[0][d][4 * g4 + 2] * rs * gg[2], O[0][d][4 * g4 + 3] * rs * gg[3])};
                *(u32x2*)(yr + dv) = w;
            }
    } else {
#pragma unroll
        for (int s = 0; s < 2; ++s) {
            bf16_t* yr = Yb + (size_t)(wave * 64 + s * 32 + l32e) * YW;
#pragma unroll
            for (int d = 0; d < NDVB; ++d)
#pragma unroll
                for (int g4 = 0; g4 < 4; ++g4) {
                    const int dv = d * 32 + g4 * 8 + halfe * 4;
                    u32x2 w = {pk2(O[s][d][4 * g4] * inv[s], O[s][d][4 * g4 + 1] * inv[s]), pk2(O[s][d][4 * g4 + 2] * inv[s], O[s][d][4 * g4 + 3] * inv[s])};
                    *(u32x2*)(yr + dv) = w;
                }
        }
    }
}

DI int mapcol(int kind, int n) {
    switch (kind) {
        case 1: { const int pn = n >> 8, r = n & 255; return r < 128 ? pn * 128 + r : DFF + pn * 128 + (r - 128); }
        case 2: return n < 1024 ? n : n < 1408 ? 1536 + (n - 1024) : n < 1440 ? 2176 + (n - 1408) : n < 1536 ? -1 : n < 1792 ? 1920 + (n - 1536) : 2720 + (n - 1792);
        case 3: return 1024 + n;
        case 4: return (n >> 6) * 128 + (n & 63);
        case 5: return (n >> 6) * 128 + 64 + (n & 63);
        default: return n;
    }
}
DI void prepT(LAS float* tile, bf16_t* dst, int ldd, const float* src, int lds_, int Kd, int Nd, int kind, const float* kscale, int& rot) {
    int tid = threadIdx.x; asm volatile("" : "+v"(tid));
    const int G = gridDim.x, ntk = Kd >> 6, ntiles = ntk * (Nd >> 7);
    for (int t = (int)((blockIdx.x + (unsigned)G - (unsigned)(rot % G)) % (unsigned)G); t < ntiles; t += G) {
        const int k0 = (t % ntk) << 6, n0 = (t / ntk) << 7;
        const int n4 = (tid & 31) * 4, sc = mapcol(kind, n0 + n4);
        f32x4 v[4];
#pragma unroll
        for (int ps = 0; ps < 4; ++ps) {
            const int kk = ps * 16 + (tid >> 5);
            v[ps] = sc >= 0 ? *(const f32x4*)(src + (size_t)(k0 + kk) * lds_ + sc) : (f32x4){0.f, 0.f, 0.f, 0.f};
            if (kscale) v[ps] *= kscale[k0 + kk];
        }
#pragma unroll
        for (int ps = 0; ps < 4; ++ps) {
            const int kk = ps * 16 + (tid >> 5);
#pragma unroll
            for (int i = 0; i < 4; ++i) tile[kk * 129 + n4 + i] = v[ps][i];
        }
        __syncthreads();
#pragma unroll
        for (int h = 0; h < 2; ++h) {
            const int ch = tid + h * NT, on = ch >> 3, kc = ch & 7;
            u32x4 w;
            w.x = pk2(tile[(kc * 8 + 0) * 129 + on], tile[(kc * 8 + 1) * 129 + on]); w.y = pk2(tile[(kc * 8 + 2) * 129 + on], tile[(kc * 8 + 3) * 129 + on]);
            w.z = pk2(tile[(kc * 8 + 4) * 129 + on], tile[(kc * 8 + 5) * 129 + on]); w.w = pk2(tile[(kc * 8 + 6) * 129 + on], tile[(kc * 8 + 7) * 129 + on]);
            *(u32x4*)(dst + (size_t)(n0 + on) * ldd + k0 + kc * 8) = w;
        }
        __syncthreads();
    }
    rot += ntiles;
}

DI void prologue(const Params& p, LAS unsigned char* lds) {
    int tid = threadIdx.x; asm volatile("" : "+v"(tid));
    const int G = gridDim.x, bid = blockIdx.x;
    const size_t gtid = (size_t)bid * NT + tid, gsz = (size_t)G * NT;
    unsigned char* ws = p.ws;
    {
        f32x4* H = (f32x4*)(ws + OFF_H);
        for (size_t i = gtid; i < (size_t)T * 256; i += gsz) {
            const int t = (int)(i >> 8), c4 = (int)(i & 255), b = t / TPB, r = t - b * TPB;
            H[i] = r < CTX ? ((const f32x4*)p.ctx)[((size_t)b * CTX + r) * 256 + c4] : ((const f32x4*)p.x)[((size_t)b * SEQ + (r - CTX)) * 256 + c4];
        }
    }
    {
        float* RD = (float*)(ws + OFF_ROPED); float* RM = (float*)(ws + OFF_ROPEM);
        for (size_t i = gtid; i < (size_t)2048 * 32; i += gsz) {
            const int pos = (int)(i >> 5), e = (int)(i & 31), sel = e >> 4, j = e & 15;
            const float fr = __powf(10000.f, -(float)j / 16.f), ang = (float)(sel ? (pos & 63) : (pos >> 6)) * fr, rev = ang * 0.15915494309189535f;
            RD[2 * i] = __builtin_amdgcn_cosf(rev); RD[2 * i + 1] = __builtin_amdgcn_sinf(rev);
        }
        for (size_t i = gtid; i < (size_t)2048 * 16; i += gsz) {
            const int pos = (int)(i >> 4), e = (int)(i & 15), sel = e >> 3, j = e & 7;
            const float fr = __powf(10000.f, -(float)j / 8.f), ang = (float)(sel ? (pos & 63) : (pos >> 6)) * fr, rev = ang * 0.15915494309189535f;
            RM[2 * i] = __builtin_amdgcn_cosf(rev); RM[2 * i + 1] = __builtin_amdgcn_sinf(rev);
        }
    }
    {
        u32x4* DL = (u32x4*)(ws + OFF_DFTL);
        for (size_t i = gtid; i < (size_t)2048 * 512; i += gsz) {
            const int k = (int)(i >> 9), c8 = (int)(i & 511) * 8, part = c8 >> 11, n0 = c8 & 2047;
            float v[8];
#pragma unroll
            for (int j = 0; j < 8; ++j) { const float fr = (float)((k * (n0 + j)) & 2047) * (1.0f / 2048.0f);
                v[j] = (part ? -__builtin_amdgcn_sinf(fr) : __builtin_amdgcn_cosf(fr)) * 0.022097086912079608f; }
            DL[i] = (u32x4){pk2(v[0], v[1]), pk2(v[2], v[3]), pk2(v[4], v[5]), pk2(v[6], v[7])};
        }
        u32x4* DC = (u32x4*)(ws + OFF_DFTC);
        for (size_t i = gtid; i < (size_t)256 * 64; i += gsz) {
            const int k = (int)(i >> 6), c8 = (int)(i & 63) * 8, part = c8 >> 8, n0 = c8 & 255;
            float v[8];
#pragma unroll
            for (int j = 0; j < 8; ++j) { const float fr = (float)((k * (n0 + j)) & 255) * (1.0f / 256.0f);
                v[j] = (part ? -__builtin_amdgcn_sinf(fr) : __builtin_amdgcn_cosf(fr)) * 0.0625f; }
            DC[i] = (u32x4){pk2(v[0], v[1]), pk2(v[2], v[3]), pk2(v[4], v[5]), pk2(v[6], v[7])};
        }
    }
    if (bid == 0 && tid < DEPTH) {
        const float* dl = p.diff_lambda + tid * 4 * 64; float a = 0.f, b = 0.f;
        for (int i = 0; i < 64; ++i) { a += dl[i] * dl[64 + i]; b += dl[128 + i] * dl[192 + i]; }
        const float lam_init = 0.8f - 0.6f * expf(-0.3f * (float)tid);
        ((float*)(ws + OFF_LAM))[tid] = expf(a) - expf(b) + lam_init;
        ((float*)(ws + OFF_LAM))[4 + tid] = 1.0f - lam_init;
    }
    {
        LAS float* sc = (LAS float*)lds;
        LAS float* red = (LAS float*)(lds + 40960);
        for (int i = tid; i < 9 * 1024; i += NT) { const float v = i < 8192 ? p.c[i] : p.c_ctx[i - 8192]; sc[i] = v * sigmoidf_(v); }
        __syncthreads();
        float* MOD = (float*)(ws + OFF_MOD);
        for (int it = bid; it < DEPTH * 144; it += G) {
            const int l = it / 144, n0 = (it % 144) * 64, col = tid & 63, kg = tid >> 6;
            const float* w = p.ada_w + (size_t)l * 1024 * 9216 + n0 + col;
            float a[9];
#pragma unroll
            for (int r = 0; r < 9; ++r) a[r] = 0.f;
            for (int k8 = kg * 128; k8 < kg * 128 + 128; k8 += 8) {
                float wv[8];
#pragma unroll
                for (int j = 0; j < 8; ++j) wv[j] = w[(size_t)(k8 + j) * 9216];
#pragma unroll
                for (int j = 0; j < 8; ++j)
#pragma unroll
                    for (int r = 0; r < 9; ++r) a[r] += sc[r * 1024 + k8 + j] * wv[j];
            }
#pragma unroll
            for (int r = 0; r < 9; ++r) red[(kg * 9 + r) * 64 + col] = a[r];
            __syncthreads();
            for (int o = tid; o < 576; o += NT) {
                const int r = o >> 6, cc = o & 63; float s = p.ada_b[l * 9216 + n0 + cc];
#pragma unroll
                for (int g = 0; g < 8; ++g) s += red[(g * 9 + r) * 64 + cc];
                MOD[((size_t)l * 9 + r) * 9216 + n0 + cc] = s;
            }
            __syncthreads();
        }
    }
    {
        LAS float* wt = (LAS float*)lds;
        LAS float* tc = (LAS float*)(lds + 16384);
        LAS bf16_t* ot = (LAS bf16_t*)(lds + 20480);
        for (int i = tid; i < 128; i += NT) { tc[i] = __builtin_amdgcn_cosf((float)i * (1.0f / 128.0f)); tc[128 + i] = __builtin_amdgcn_sinf((float)i * (1.0f / 128.0f)); }
        for (int it = bid; it < DEPTH * 4 * 32; it += G) {
            const int l = it >> 7, g = (it >> 5) & 3, k0 = (it & 31) * 32;
            __syncthreads();
            for (int i = tid; i < 32 * 128; i += NT) wt[i] = p.w_in[((size_t)l * 1024 + k0 + (i >> 7)) * INW + 2208 + g * 128 + (i & 127)];
            __syncthreads();
            const int pmi = tid & 255, part = pmi >> 7, m = pmi & 127, kh = tid >> 8;
            float a[16];
#pragma unroll
            for (int i = 0; i < 16; ++i) a[i] = 0.f;
            for (int c = 0; c < 128; ++c) {
                const float tv = tc[part * 128 + ((m * c) & 127)];
#pragma unroll
                for (int i = 0; i < 16; ++i) a[i] += wt[(2 * i + kh) * 128 + c] * tv;
            }
#pragma unroll
            for (int i = 0; i < 16; ++i) { const unsigned w = pk2(a[i] * 0.08838834764831845f, 0.f); ot[pmi * 32 + 2 * i + kh] = (bf16_t)(w & 0xffffu); }
            __syncthreads();
            bf16_t* AF = (bf16_t*)(ws + OFF_W) + (size_t)l * WE_END + WE_F;
            for (int ch = tid; ch < 1024; ch += NT) {
                const int r = ch >> 2, q = ch & 3;
                *(u32x4*)(AF + (size_t)(g * 256 + r) * 1024 + k0 + q * 8) = *(const LAS u32x4*)(ot + r * 32 + q * 8);
            }
        }
        __syncthreads();
    }
    {
        LAS float* tile = (LAS float*)lds; int rot = 0;
        for (int l = 0; l < DEPTH; ++l) {
            bf16_t* W = (bf16_t*)(ws + OFF_W) + (size_t)l * WE_END;
            for (int s = 0; s < 2; ++s) {
                prepT(tile, W + WE_W1 + (size_t)s * 5632 * 1024, 1024, p.ffn_w_in + ((size_t)l * 2 + s) * 1024 * 5632, 5632, 1024, 5632, 1, nullptr, rot);
                prepT(tile, W + WE_W2 + (size_t)s * 1024 * 2816, 2816, p.ffn_w_out + ((size_t)l * 2 + s) * 2816 * 1024, 1024, 2816, 1024, 0, nullptr, rot);
            }
            const float* win = p.w_in + (size_t)l * 1024 * INW;
            prepT(tile, W + WE_IN, 1024, win, INW, 1024, 4864, 2, nullptr, rot);
            prepT(tile, W + WE_V, 1024, win, INW, 1024, 512, 3, nullptr, rot);
            prepT(tile, W + WE_UQ, 384, p.mla_w_uq + (size_t)l * 384 * 768, 768, 384, 768, 0, p.mla_q_norm_g + l * 384, rot);
            prepT(tile, W + WE_UK, 256, p.mla_w_ukv + (size_t)l * 256 * 1024, 1024, 256, 512, 4, p.mla_kv_norm_g + l * 256, rot);
            prepT(tile, W + WE_UV, 256, p.mla_w_ukv + (size_t)l * 256 * 1024, 1024, 256, 512, 5, p.mla_kv_norm_g + l * 256, rot);
            prepT(tile, W + WE_B, 2048, p.w_bd + (size_t)l * 512 * 1024, 1024, 512, 1024, 0, nullptr, rot);
            prepT(tile, W + WE_B + 512, 2048, p.w_bm + (size_t)l * 512 * 1024, 1024, 512, 1024, 0, nullptr, rot);
            prepT(tile, W + WE_B + 1024, 2048, p.w_bf + (size_t)l * 512 * 1024, 1024, 512, 1024, 0, nullptr, rot);
            prepT(tile, W + WE_B + 1536, 2048, p.w_bf + (size_t)l * 512 * 1024, 1024, 512, 1024, 0, nullptr, rot);
            prepT(tile, W + WE_O, 1024, p.w_out + (size_t)l * 1024 * 1024, 1024, 1024, 1024, 0, nullptr, rot);
        }
    }
}

DI void norm_phase(const Params& p, const float* gain, const float* modl, int sh_i, int sc_i, bool zero) {
    int tid = threadIdx.x; asm volatile("" : "+v"(tid));
    const int lane = tid & 63, gw = blockIdx.x * 8 + (tid >> 6), nw = gridDim.x * 8;
    const float* H = (const float*)(p.ws + OFF_H); bf16_t* AN = (bf16_t*)(p.ws + OFF_AN);
    f32x4 g[4];
#pragma unroll
    for (int j = 0; j < 4; ++j) g[j] = *(const f32x4*)(gain + (lane + 64 * j) * 4);
    for (int t0 = gw; t0 < T; t0 += nw * 4) {
        f32x4 v[4][4]; float ss[4];
#pragma unroll
        for (int r = 0; r < 4; ++r) {
            const int t = t0 + r * nw; const bool ok = t < T;
            const f32x4* hr = (const f32x4*)(H + (size_t)(ok ? t : t0) * DM);
#pragma unroll
            for (int j = 0; j < 4; ++j) v[r][j] = hr[lane + 64 * j];
        }
#pragma unroll
        for (int r = 0; r < 4; ++r) {
            float s = 0.f;
#pragma unroll
            for (int j = 0; j < 4; ++j) s += v[r][j][0] * v[r][j][0] + v[r][j][1] * v[r][j][1] + v[r][j][2] * v[r][j][2] + v[r][j][3] * v[r][j][3];
            ss[r] = wave_sum(s);
        }
#pragma unroll
        for (int r = 0; r < 4; ++r) {
            const int t = t0 + r * nw;
            if (t < T) {
                const float rs = __builtin_amdgcn_rsqf(ss[r] * (1.0f / 1024.0f) + RMS_EPS);
                const int b = t / TPB, rr = t - b * TPB, mrow = rr < CTX ? 8 : b;
                const float* sh = modl + (size_t)mrow * 9216 + sh_i * 1024; const float* sc = modl + (size_t)mrow * 9216 + sc_i * 1024;
#pragma unroll
                for (int j = 0; j < 4; ++j) {
                    const int c = (lane + 64 * j) * 4;
                    const f32x4 s1 = *(const f32x4*)(sc + c), s0 = *(const f32x4*)(sh + c);
                    const f32x4 y = (v[r][j] * rs * g[j]) * (s1 + 1.0f) + s0;
                    *(u32x2*)(AN + (size_t)t * DM + c) = (u32x2){pk2(y[0], y[1]), pk2(y[2], y[3])};
                }
            }
        }
    }
    if (zero) {
        float* a = (float*)(p.ws + OFF_RSQ);
        for (size_t i = (size_t)blockIdx.x * NT + tid; i < (size_t)2 * T; i += (size_t)gridDim.x * NT) a[i] = 0.f;
    }
}
DI void final_phase(const Params& p) {
    int tid = threadIdx.x; asm volatile("" : "+v"(tid));
    const int lane = tid & 63, gw = blockIdx.x * 8 + (tid >> 6), nw = gridDim.x * 8;
    const float* H = (const float*)(p.ws + OFF_H);
    for (int q = gw; q < NB * SEQ; q += nw) {
        const int b = q >> 11, n = q & 2047;
        const f32x4* hr = (const f32x4*)(H + ((size_t)b * TPB + CTX + n) * DM);
        f32x4 v[4]; float ss = 0.f;
#pragma unroll
        for (int j = 0; j < 4; ++j) { v[j] = hr[lane + 64 * j]; ss += v[j][0] * v[j][0] + v[j][1] * v[j][1] + v[j][2] * v[j][2] + v[j][3] * v[j][3]; }
        ss = wave_sum(ss);
        const float rs = __builtin_amdgcn_rsqf(ss * (1.0f / 1024.0f) + RMS_EPS);
#pragma unroll
        for (int j = 0; j < 4; ++j) { const int c = (lane + 64 * j) * 4; *(f32x4*)(p.out + (size_t)q * DM + c) = v[j] * rs * *(const f32x4*)(p.final_g + c); }
    }
}

#define XB_TMO      128
#define XB_XCNT(j)  (256  + 64 * (j))
#define XB_XSUB(j)  (1280 + 64 * (j))
#define XB_XGEN(j)  (2304 + 64 * (j))
#define XB_TOP      3328
#define XB_TOPGEN   3392
#define XB_SPIN_CAP (1u << 22)
DI unsigned xb_ld(unsigned* p) { return __hip_atomic_load(p, __ATOMIC_RELAXED, __HIP_MEMORY_SCOPE_AGENT); }
DI unsigned xb_add(unsigned* p, unsigned v) { return __hip_atomic_fetch_add(p, v, __ATOMIC_RELAXED, __HIP_MEMORY_SCOPE_AGENT); }
DI unsigned xb_xcc_id() { return (unsigned)__builtin_amdgcn_s_getreg((3 << 11) | 20) & 0xFu; }
#define XB_SPIN(cond, bar) do { unsigned _sp = 0; while (cond) { __builtin_amdgcn_s_sleep(1); \
    if ((++_sp & 255u) == 0u) { if (xb_ld(&(bar)[XB_TMO])) break; if (_sp > XB_SPIN_CAP) { atomicAdd(&(bar)[XB_TMO], 1u); break; } } } } while (0)
struct XcdBarrier { unsigned* bar; unsigned x; volatile LAS unsigned* st; };
DI XcdBarrier xcd_barrier_post(unsigned* bar, volatile LAS unsigned* st) {
    XcdBarrier b; b.bar = bar; b.x = xb_xcc_id(); b.st = st;
    if (threadIdx.x == 0) (void)xb_add(&bar[XB_XCNT(b.x)], 1u);
    return b;
}
DI void xcd_barrier_complete(unsigned* bar, unsigned x, unsigned& nloc, unsigned& nx) {
    const unsigned G = gridDim.x * gridDim.y * gridDim.z;
    unsigned sum, cnt, mine, sp = 0u;
    for (;;) {
        sum = 0u; cnt = 0u; mine = 0u;
#pragma unroll
        for (unsigned j = 0; j < 16; ++j) { const unsigned c = xb_ld(&bar[XB_XCNT(j)]); sum += c; cnt += (c > 0u) ? 1u : 0u; mine = (j == x) ? c : mine; }
        if (sum == G) break;
        __builtin_amdgcn_s_sleep(1);
        if ((++sp & 255u) == 0u) { if (xb_ld(&bar[XB_TMO])) break; if (sp > XB_SPIN_CAP) { atomicAdd(&bar[XB_TMO], 1u); break; } }
    }
    nloc = mine > 0u ? mine : 1u; nx = cnt > 0u ? cnt : 1u;
}
DI void xcd_barrier(const XcdBarrier& b) {
    asm volatile("s_waitcnt vmcnt(0)" ::: "memory");
    __syncthreads();
    if (threadIdx.x == 0) {
        unsigned* bar = b.bar;
        __builtin_amdgcn_s_waitcnt(0);
        unsigned nloc = b.st[0], nx = b.st[1];
        if (nloc == 0u) { xcd_barrier_complete(bar, b.x, nloc, nx); b.st[0] = nloc; b.st[1] = nx; }
        const unsigned old = xb_add(&bar[XB_XSUB(b.x)], 1u);
        const unsigned gen = old / nloc;
        if (old + 1u == (gen + 1u) * nloc) {
            __builtin_amdgcn_fence(__ATOMIC_RELEASE, "agent");
            asm volatile("s_waitcnt vmcnt(0)" ::: "memory");
            const unsigned og = xb_add(&bar[XB_TOP], 1u);
            const unsigned tg = og / nx;
            if (og + 1u == (tg + 1u) * nx) xb_add(&bar[XB_TOPGEN], 1u);
            else XB_SPIN(xb_ld(&bar[XB_TOPGEN]) == tg, bar);
            __builtin_amdgcn_fence(__ATOMIC_ACQUIRE, "agent");
            xb_add(&bar[XB_XGEN(b.x)], 1u);
            asm volatile("s_waitcnt vmcnt(0)" ::: "memory");
        } else {
            XB_SPIN(xb_ld(&bar[XB_XGEN(b.x)]) == gen, bar);
            __builtin_amdgcn_fence(__ATOMIC_ACQUIRE, "agent");
            asm volatile("s_waitcnt vmcnt(0)" ::: "memory");
        }
    }
    __syncthreads();
}

constexpr int NPH = 2 + 12 * DEPTH;
#ifndef PH_MASK
#define PH_MASK 0xffff
#endif
#define EN(k) (((PH_MASK) >> (k)) & 1)
#ifndef ATT_MASK
#define ATT_MASK 0xf
#endif
#define AEN(k) (((ATT_MASK) >> (k)) & 1)
__global__ void __launch_bounds__(NT, 2) fwd_kernel(Params p) {
    extern __shared__ __attribute__((aligned(16))) unsigned char shm[];
    LAS unsigned char* lds = (LAS unsigned char*)shm;
    const int G = gridDim.x, bid = blockIdx.x;
    if (threadIdx.x < 4) ((LAS unsigned*)(lds + LDS_MAIN))[threadIdx.x] = 0u;
    __syncthreads();
    XcdBarrier xbar = xcd_barrier_post((unsigned*)(p.ws + OFF_BAR), (volatile LAS unsigned*)(lds + LDS_MAIN));
    for (int ph = p.ph_lo; ph < p.ph_hi; ++ph) {
      for (int rep_ = 0; rep_ < REPS(ph); ++rep_) {
        unsigned char* ws = p.ws; asm volatile("" : "+s"(ws));
        float* H = (float*)(ws + OFF_H); bf16_t* AN = (bf16_t*)(ws + OFF_AN); bf16_t* MG = AN;
        bf16_t* ACT = (bf16_t*)(ws + OFF_R1); bf16_t* GT = (bf16_t*)(ws + OFF_R1);
        bf16_t* QD = (bf16_t*)(ws + OFF_QD); bf16_t* KD = (bf16_t*)(ws + OFF_KD); bf16_t* VTD = (bf16_t*)(ws + OFF_VTD);
        bf16_t* FT = (bf16_t*)(ws + OFF_FT); bf16_t* FTC = (bf16_t*)(ws + OFF_FTC);
        bf16_t* QM = (bf16_t*)(ws + OFF_QM); bf16_t* KM = (bf16_t*)(ws + OFF_KM); bf16_t* VTM = (bf16_t*)(ws + OFF_VTM);
        bf16_t* Y = (bf16_t*)(ws + OFF_Y); bf16_t* PQ = (bf16_t*)(ws + OFF_PQ); bf16_t* CKV = (bf16_t*)(ws + OFF_CKV);
        float* RSQ = (float*)(ws + OFF_RSQ); float* RSKV = (float*)(ws + OFF_RSKV);
        const float* RD = (const float*)(ws + OFF_ROPED); const float* RM = (const float*)(ws + OFF_ROPEM);
        const float* LAM = (const float*)(ws + OFF_LAM);
        const bf16_t* DFTL = (const bf16_t*)(ws + OFF_DFTL); const bf16_t* DFTC = (const bf16_t*)(ws + OFF_DFTC);

        if (ph == 0) { if (EN(12)) prologue(p, lds); }
        else if (ph == NPH - 1) { if (EN(13)) final_phase(p); }
        else {
            const int l = (ph - 1) / 12, sp = (ph - 1) % 12;
            const float* modl = (const float*)(ws + OFF_MOD) + (size_t)l * 9 * 9216;
            const bf16_t* W = (const bf16_t*)(ws + OFF_W) + (size_t)l * WE_END;
            pg8::Sched S; S.ns = 1; S.G = G; S.c = bid; S.rep = 1; S.za = 0; S.zb = 0;
            if (EN(0) && (sp == 0 || sp == 3 || sp == 9)) {
                const int ni = sp == 0 ? 0 : sp == 3 ? 1 : 2;
                norm_phase(p, p.norm_g + ((size_t)l * 3 + ni) * DM, modl, 3 * ni, 3 * ni + 1, sp == 3);
            } else if (EN(1) && (sp == 1 || sp == 10)) {
                const int s = sp == 1 ? 0 : 1; const bool lo = (l == DEPTH - 1 && s == 1);
                S.s0 = pg8::mksub(AN, W + WE_W1 + (size_t)s * 5632 * 1024, lo ? 64 : 72, 22, 1024, 1024); S.s0.mapM = lo ? 1 : 0;
                EpiSwiglu E{ACT};
                pg8::gemm_phase(lds, 1024, 1024, 1024, S, E);
            } else if (EN(2) && (sp == 2 || sp == 11)) {
                const int s = sp == 2 ? 0 : 1; const bool lo = (l == DEPTH - 1 && s == 1);
                S.s0 = pg8::mksub(ACT, W + WE_W2 + (size_t)s * 1024 * 2816, lo ? 64 : 72, 4, 2816, 2816); S.s0.mapM = lo ? 1 : 0;
                EpiResid E{H, modl, s == 0 ? 2 : 8, rep_ ? 0.f : 0.5f, 0};
                pg8::gemm_phase(lds, 2816, 2816, 2816, S, E);
            } else if (EN(4) && sp == 4) {
                S.ns = 3;
                S.s0 = pg8::mksub(AN, W + WE_IN, 72, 19, 1024, 1024);
                S.s1 = pg8::mksub(W + WE_V, AN, 2, 72, 1024, 1024);
                S.s2 = pg8::mksub(W + WE_F, AN, 4, 72, 1024, 1024);
                EpiIn E{QD, KD, PQ, CKV, GT, KM, VTD, FT, FTC, RSQ, RSKV, RD, RM};
                pg8::gemm_phase(lds, 1024, 1024, 1024, S, E);
            } else if (EN(5) && sp == 5) {
                for (int cx = 0; cx < 2; ++cx) {
                    S.ns = cx ? 2 : 1; S.c = cx ? (bid + 216) % G : bid;
                    S.s0 = cx ? pg8::mksub(CKV, W + WE_UK, 72, 2, 256, 256) : pg8::mksub(PQ, W + WE_UQ, 72, 3, 512, 384);
                    S.s1 = pg8::mksub(W + WE_UV, CKV, 2, 72, 256, 256);
                    EpiUp E{QM, KM, VTM, RSQ, RSKV, RM, cx};
                    pg8::gemm_phase(lds, cx ? 256 : 384, cx ? 256 : 512, cx ? 256 : 384, S, E);
                }
            } else if (EN(6) && sp == 6) {
                const float lam = LAM[l], outfac = LAM[4 + l];
                const bool lastl = (l == DEPTH - 1);
                if (AEN(0)) for (int i0 = bid; i0 < (lastl ? 256 : 288); i0 += G) {
                    const bool lat = i0 < 256; const int it = lat ? ((G == 256) ? ((i0 & 7) * 32 + (i0 >> 3)) : i0) : i0 - 256;
                    const int b = lat ? it >> 5 : it >> 2, h = lat ? (it >> 3) & 3 : it & 3, qt = it & 7;
                    const size_t rb = (size_t)b * TPB, r0 = lat ? rb + CTX + qt * 256 : rb;
                    attn_item<64, 128, true>(lds, QD + r0 * 512 + h * 128, 512, KD + rb * 512 + h * 128, 512, VTD + (size_t)(b * 4 + h) * 128 * TPB, lat ? TPB : CTX, 256,
                                             Y + r0 * YW + h * 128, lam, outfac, p.diff_subln_g + l * 128);
                }
                if (AEN(1)) for (int i1 = bid; i1 < (lastl ? 256 : 320); i1 += G) {
                    const int i0 = lastl ? i1 : (i1 + 32) % 320;
                    const bool lat = i0 < 256; const int it = lat ? ((G == 256) ? ((i0 & 7) * 32 + (i0 >> 3)) : i0) : i0 - 256;
                    const int b = lat ? it >> 5 : it >> 3, h = lat ? (it >> 2) & 7 : it & 7, qt = it & 3;
                    const size_t rb = (size_t)b * TPB, r0 = lat ? rb + CTX + qt * 512 : rb;
                    attn_item<96, 64, false>(lds, QM + r0 * 768 + h * 96, 768, KM + rb * 768 + h * 96, 768, VTM + (size_t)(b * 8 + h) * 64 * TPB, lat ? TPB : CTX, lat ? 512 : 256,
                                             Y + r0 * YW + 512 + h * 64, 0.f, 1.f, nullptr);
                }
                __syncthreads();
                if (AEN(3)) for (int cx = 0; cx < (lastl ? 1 : 2); ++cx) {
                    const int Kf = cx ? 512 : 2048, ldf = cx ? 512 : 4096;
                    S.c = cx ? (bid + 240) % G : bid;
                    S.s0 = pg8::mksub(cx ? DFTC : DFTL, cx ? FTC : FT, cx ? 8 : 128, 2, ldf, ldf); S.s0.mmod = cx ? 1 : 8; S.s0.mode = cx ? 0 : 1; S.s0.zb = (size_t)512 * ldf * 2;
                    EpiF2 E1{Y, cx};
                    pg8::gemm_phase(lds, Kf, ldf, ldf, S, E1);
                }
            } else if (EN(7) && sp == 7) {
                const bool lo = (l == DEPTH - 1);
                S.s0 = pg8::mksub(Y, W + WE_B, lo ? 64 : 72, 4, YW, 2048); S.s0.mapM = lo ? 1 : 0;
                EpiMerge E{MG, GT};
                pg8::gemm_phase(lds, 2048, YW, 2048, S, E);
            } else if (EN(8) && sp == 8) {
                const bool lo = (l == DEPTH - 1);
                S.s0 = pg8::mksub(MG, W + WE_O, lo ? 64 : 72, 4, 1024, 1024); S.s0.mapM = lo ? 1 : 0;
                EpiResid E{H, modl, 5, rep_ ? 0.f : 1.0f, 0};
                pg8::gemm_phase(lds, 1024, 1024, 1024, S, E);
            }
        }
        if (ph + 1 < p.ph_hi) { if (ph == 0 && rep_ == 0) cg::this_grid().sync(); else xcd_barrier(xbar); }
      }
    }
}

extern "C" void kernel_launch(void* const* d_in, const int* in_sizes, int n_in, void* d_out, int out_size, void* d_ws, size_t ws_size, hipStream_t stream) {
    static int grid = 0;
    if (grid == 0) {
        if (ws_size < WS_NEED) { fprintf(stderr, "kernel_launch: workspace too small: need %zu have %zu\n", (size_t)WS_NEED, ws_size); grid = -1; return; }
        int dev = 0, cus = 0, per_cu = 0;
        hipGetDevice(&dev); hipDeviceGetAttribute(&cus, hipDeviceAttributeMultiprocessorCount, dev);
        if (hipFuncSetAttribute((const void*)fwd_kernel, hipFuncAttributeMaxDynamicSharedMemorySize, LDS_BYTES) != hipSuccess) { fprintf(stderr, "kernel_launch: hipFuncSetAttribute failed\n"); grid = -1; return; }
        if (hipOccupancyMaxActiveBlocksPerMultiprocessor(&per_cu, (const void*)fwd_kernel, NT, LDS_BYTES) != hipSuccess || per_cu < 1) { fprintf(stderr, "kernel_launch: occupancy query says %d\n", per_cu); per_cu = 1; }
        (void)hipGetLastError();
        grid = cus * per_cu;
        fprintf(stderr, "kernel_launch: grid %d (cus %d x %d), ws need %zu have %zu\n", grid, cus, per_cu, (size_t)WS_NEED, ws_size);
    }
    if (grid < 0) return;
    Params p{};
    const float** pp = (const float**)&p;
    for (int i = 0; i < 21; ++i) pp[i] = (const float*)d_in[i];
    p.out = (float*)d_out; p.ws = (unsigned char*)d_ws;
#if ONE_LAUNCH
    if (hipMemsetAsync((char*)d_ws + OFF_BAR, 0, BAR_BYTES, stream) != hipSuccess) { fprintf(stderr, "kernel_launch: memset of the barrier words failed\n"); return; }
    p.ph_lo = 0; p.ph_hi = NPH;
    void* args[] = {&p};
    hipError_t e = hipLaunchCooperativeKernel((const void*)fwd_kernel, dim3(grid), dim3(NT), args, LDS_BYTES, stream);
    if (e != hipSuccess) fprintf(stderr, "cooperative launch failed: %s (grid %d)\n", hipGetErrorString(e), grid);
#else
    for (int ph = 0; ph < NPH; ++ph) {
        p.ph_lo = ph; p.ph_hi = ph + 1;
        hipLaunchKernelGGL(fwd_kernel, dim3(grid), dim3(NT), LDS_BYTES, stream, p);
    }
#endif
}
```

```cpp
#include <hip/hip_runtime.h>
#include <hip/hip_cooperative_groups.h>
#include <cstdio>
namespace cg = cooperative_groups;

#define REPS(ph) 1
#ifndef ONE_LAUNCH
#define ONE_LAUNCH 1
#endif

#define LAS __attribute__((address_space(3)))
#define DI __device__ __forceinline__
typedef unsigned short bf16_t;
typedef short bf16x8 __attribute__((ext_vector_type(8)));
typedef float f32x4 __attribute__((ext_vector_type(4)));
typedef float f32x16 __attribute__((ext_vector_type(16)));
typedef unsigned u32x4 __attribute__((ext_vector_type(4)));
typedef unsigned u32x2 __attribute__((ext_vector_type(2)));

constexpr int DM = 1024, NB = 8, SEQ = 2048, CTX = 256, TPB = SEQ + CTX  , T = NB * TPB  ;
constexpr int DEPTH = 4, DFF = 2816, INW = 5792, NMOD = 9;
constexpr int NT = 512;
constexpr int YW = 2048;
constexpr int LDS_MAIN = 147456;
constexpr int LDS_BYTES = LDS_MAIN + 256;
constexpr float RMS_EPS = 1e-6f;

constexpr size_t al256(size_t x) { return (x + 255) & ~(size_t)255; }
constexpr size_t OFF_H = 0;
constexpr size_t OFF_AN = OFF_H + (size_t)T * DM * 4;
constexpr size_t OFF_R1 = OFF_AN + (size_t)T * DM * 2;
constexpr size_t OFF_QD = OFF_R1 + (size_t)T * 3072 * 2;
constexpr size_t OFF_KD = OFF_QD + (size_t)T * 512 * 2;
constexpr size_t OFF_VTD = OFF_KD + (size_t)T * 512 * 2;
constexpr size_t OFF_FT = OFF_VTD + (size_t)T * 512 * 2;
constexpr size_t OFF_FTC = OFF_FT + (size_t)NB * 512 * 4096 * 2;
constexpr size_t OFF_QM = OFF_FTC + (size_t)NB * 512 * 512 * 2;
constexpr size_t OFF_KM = OFF_QM + (size_t)T * 768 * 2;
constexpr size_t OFF_VTM = OFF_KM + (size_t)T * 768 * 2;
constexpr size_t OFF_Y = OFF_VTM + (size_t)T * 512 * 2;
constexpr size_t OFF_PQ = OFF_Y;
constexpr size_t OFF_CKV = OFF_PQ + (size_t)512 * 2;
constexpr size_t OFF_RSQ = OFF_Y + (size_t)T * YW * 2;
constexpr size_t OFF_RSKV = OFF_RSQ + (size_t)T * 4;
constexpr size_t OFF_MOD = OFF_RSKV + (size_t)T * 4;
constexpr size_t OFF_ROPED = OFF_MOD + (size_t)DEPTH * 9 * 9216 * 4;
constexpr size_t OFF_ROPEM = OFF_ROPED + (size_t)2048 * 32 * 8;
constexpr size_t OFF_LAM = OFF_ROPEM + (size_t)2048 * 16 * 8;
constexpr size_t OFF_DFTL = OFF_LAM + 256;
constexpr size_t OFF_DFTC = OFF_DFTL + (size_t)2048 * 4096 * 2;
constexpr size_t OFF_W = OFF_DFTC + (size_t)256 * 512 * 2;
constexpr size_t WE_W1 = 0;
constexpr size_t WE_W2 = WE_W1 + (size_t)2 * 5632 * 1024;
constexpr size_t WE_IN = WE_W2 + (size_t)2 * 1024 * 2816;
constexpr size_t WE_V = WE_IN + (size_t)4864 * 1024;
constexpr size_t WE_F = WE_V + (size_t)512 * 1024;
constexpr size_t WE_UQ = WE_F + (size_t)1024 * 1024;
constexpr size_t WE_UK = WE_UQ + (size_t)768 * 384;
constexpr size_t WE_UV = WE_UK + (size_t)512 * 2048;
constexpr size_t WE_B = WE_UV + (size_t)512 * 2048;
constexpr size_t WE_O = WE_B + (size_t)1024 * 2048;
constexpr size_t WE_END = WE_O + (size_t)1024 * 1024;
constexpr size_t OFF_BAR = OFF_W + (size_t)DEPTH * WE_END * 2;
constexpr size_t BAR_BYTES = 3456 * 4;
constexpr size_t WS_NEED = OFF_BAR + BAR_BYTES;

struct Params {
    const float *x, *c, *ctx, *c_ctx, *ada_w, *ada_b, *norm_g, *ffn_w_in, *ffn_w_out, *w_in, *diff_lambda, *diff_subln_g, *mla_q_norm_g, *mla_w_uq,
        *mla_kv_norm_g, *mla_w_ukv, *w_bd, *w_bm, *w_bf, *w_out, *final_g;
    float* out; unsigned char* ws; int ph_lo, ph_hi;
};

DI unsigned pk2(float a, float b) {
    typedef float f2 __attribute__((ext_vector_type(2))); typedef __bf16 b2 __attribute__((ext_vector_type(2)));
    f2 v = {a, b}; b2 r = __builtin_convertvector(v, b2); return __builtin_bit_cast(unsigned, r);
}
DI float bflo(unsigned w) { return __uint_as_float(w << 16); }
DI float bfhi(unsigned w) { return __uint_as_float(w & 0xffff0000u); }
DI void store8(bf16_t* p, f32x4 a, f32x4 b) { u32x4 w = {pk2(a[0], a[1]), pk2(a[2], a[3]), pk2(b[0], b[1]), pk2(b[2], b[3])}; *(u32x4*)p = w; }
DI void load8(const bf16_t* p, f32x4& a, f32x4& b) { const u32x4 w = *(const u32x4*)p; a = (f32x4){bflo(w.x), bfhi(w.x), bflo(w.y), bfhi(w.y)}; b = (f32x4){bflo(w.z), bfhi(w.z), bflo(w.w), bfhi(w.w)}; }
DI float fast_exp2(float x) { return __builtin_amdgcn_exp2f(x); }
DI float sigmoidf_(float x) { return __builtin_amdgcn_rcpf(1.0f + fast_exp2(-1.44269504f * x)); }
DI float wave_sum(float v) { v += __shfl_xor(v, 32); v += __shfl_xor(v, 16); v += __shfl_xor(v, 8); v += __shfl_xor(v, 4); v += __shfl_xor(v, 2); v += __shfl_xor(v, 1); return v; }

DI void rope4(f32x4& v, const float* tab, float sg, int xm) {
    f32x4 q;
#pragma unroll
    for (int i = 0; i < 4; ++i) q[i] = __shfl_xor(v[i], xm);
    const f32x4 t0 = *(const f32x4*)tab, t1 = *(const f32x4*)(tab + 4);
    v[0] = v[0] * t0[0] + sg * q[0] * t0[1]; v[1] = v[1] * t0[2] + sg * q[1] * t0[3];
    v[2] = v[2] * t1[0] + sg * q[2] * t1[1]; v[3] = v[3] * t1[2] + sg * q[3] * t1[3];
}
DI void rope8(f32x4& v0, f32x4& v1, const float* tab, bool first, int xm) {
    const float sg = first ? -1.f : 1.f;
    rope4(v0, tab, sg, xm); asm volatile("" ::: "memory");
    rope4(v1, tab + 8, sg, xm); asm volatile("" ::: "memory");
}

namespace pg8 {
constexpr int BM = 256, BK = 64, HALF = 128, HTB = HALF * BK * 2, STAGE_BYTES = 8 * HTB;
DI int lds_byte(int r, int c) { const int st = (r >> 4) * 2 + (c >> 5), rr = r & 15, cc = c & 31, ob = rr * 64 + cc * 2; return st * 1024 + (ob ^ (((ob >> 9) & 1) << 5)); }
DI void stage_rc(int b, int& R, int& C) { const int st = b / 1024, sb = b % 1024, swz = sb ^ (((sb >> 9) & 1) << 5); R = (st >> 1) * 16 + swz / 64; C = (st & 1) * 32 + (swz % 64) / 2; }
DI int perm32(int rho) { const int n = rho >> 4, i = rho & 15; return 8 * (i >> 2) + 4 * n + (i & 3); }

struct Unit { const char* a; const char* b; int pm, pn, s, z; };

struct Sub { const char* A; const char* B; int nM, nN, mmod, mode, mapM, mapN, ksplit; size_t tsa, tsb, zb, kbytes; };
struct Sched {
    Sub s0, s1, s2; int ns, G, c, rep, nb, skip; size_t za, zb;
    static DI int panel(int map, int p) { return map == 1 ? (p >> 3) * 9 + 1 + (p & 7) : map == 2 ? p * 9 : p; }
    DI bool pick(const Sub& S, int sid, long& L, int z, Unit& u) const {
        const long cnt = (long)S.nM * S.nN * S.ksplit;
        if (L >= cnt) { L -= cnt; return false; }
        const int w = (int)L / S.ksplit, zk = (int)L - w * S.ksplit, nig = 8 * S.nN, gid = w / nig, fm = gid * 8, gsz = (S.nM - fm) < 8 ? (S.nM - fm) : 8;
        u.pm = panel(S.mapM, fm + ((w % nig) % gsz)); u.pn = panel(S.mapN, (w % nig) / gsz); u.s = sid; u.z = z + zk;
        if (S.mode == 1) { const int q = u.pm >> 3; u.a = S.A + (size_t)(u.pm & 7) * S.tsa + (size_t)(q & 1) * 4096; u.b = S.B + (size_t)u.pn * S.tsb + (size_t)(q >> 1) * S.zb + (size_t)(q & 1) * 4096; }
        else {
        u.a = S.A + (size_t)(u.pm % S.mmod) * S.tsa + (size_t)z * za;
        u.b = S.B + (size_t)u.pn * S.tsb + (size_t)(u.pm / S.mmod) * S.zb + (size_t)z * zb; }
        u.a += (size_t)zk * S.kbytes; u.b += (size_t)zk * S.kbytes;
        return true;
    }
    DI bool next(int i, Unit& u) const {
        const int j = i / rep, z = i - j * rep;
        const int round = (c < nb) ? j + skip : j, ms = round < skip ? round : skip;
        long L = (long)round * G - (long)ms * nb + ((round < skip) ? (c - nb) : c);
        if (pick(s0, 0, L, z, u)) return true;
        if (ns > 1 && pick(s1, 1, L, z, u)) return true;
        if (ns > 2 && pick(s2, 2, L, z, u)) return true;
        return false;
    }
};
DI Sub mksub(const void* A, const void* B, int nM, int nN, int lda, int ldb) { Sub s; s.A = (const char*)A; s.B = (const char*)B; s.nM = nM; s.nN = nN; s.mmod = 1 << 30; s.mode = 0; s.mapM = 0; s.mapN = 0; s.ksplit = 1; s.kbytes = 0; s.tsa = (size_t)256 * lda * 2; s.tsb = (size_t)256 * ldb * 2; s.zb = 0; return s; }

template <class Epi>
DI void gemm_phase(LAS unsigned char* lds, const int K, const int lda, const int ldb, const Sched& S, const Epi& E) {
    int tid = threadIdx.x; asm volatile("" : "+v"(tid));
    const int wid = __builtin_amdgcn_readfirstlane(tid >> 6), lane = tid & 63, wr = wid >> 2, wc = wid & 3, fr = lane & 15, fq = lane >> 4;
    const int nt = K / BK;
    unsigned voffA[2], voffB[2];
#pragma unroll
    for (int i = 0; i < 2; ++i) { int R, C; stage_rc(tid * 16 + i * 8192, R, C); const int Rb = Epi::PERM ? ((R & ~31) + perm32(R & 31)) : R;
        voffA[i] = (unsigned)(R * lda + C) * 2u; voffB[i] = (unsigned)(Rb * ldb + C) * 2u; }
    const size_t kstep = (size_t)(BK * 2);
    const size_t hsA = (size_t)HALF * lda * 2, hsB = (size_t)HALF * ldb * 2;
    const unsigned ldsw = (unsigned)wid * 1024u;
    const int aoff = lds_byte(wr * 64 + fr, fq * 8), boff = lds_byte(wc * 32 + fr, fq * 8);
#define PG8_SA(b, h) (((b) * 2 + (h)) * HTB)
#define PG8_SB(b, h) ((4 + (b) * 2 + (h)) * HTB)
#define PG8_STAGE(bufoff, gbase, voff) do { _Pragma("unroll") for (int _i = 0; _i < 2; ++_i) \
        __builtin_amdgcn_global_load_lds((const unsigned*)((const char*)(gbase) + (voff)[_i]), (LAS unsigned*)(lds + (bufoff) + ldsw + _i * 8192), 16, 0, 0); } while (0)
#define PG8_LDA(dst, b, h) do { _Pragma("unroll") for (int m = 0; m < 4; ++m) _Pragma("unroll") for (int k = 0; k < 2; ++k) dst[m][k] = *(const LAS bf16x8*)(lds + PG8_SA(b, h) + aoff + m * 2048 + k * 1024); } while (0)
#define PG8_LDB(dst, b, h) do { _Pragma("unroll") for (int n = 0; n < 2; ++n) _Pragma("unroll") for (int k = 0; k < 2; ++k) dst[n][k] = *(const LAS bf16x8*)(lds + PG8_SB(b, h) + boff + n * 2048 + k * 1024); } while (0)
#define PG8_MMA(ai, bj, At, Bt) do { __builtin_amdgcn_s_setprio(1); _Pragma("unroll") for (int m = 0; m < 4; ++m) _Pragma("unroll") for (int n = 0; n < 2; ++n) _Pragma("unroll") for (int k = 0; k < 2; ++k) \
        acc[ai][bj][m][n] = __builtin_amdgcn_mfma_f32_16x16x32_bf16(Bt[n][k], At[m][k], acc[ai][bj][m][n], 0, 0, 0); __builtin_amdgcn_s_setprio(0); } while (0)
#define PG8_WAIT_V(n) asm volatile("s_waitcnt vmcnt(" #n ")" ::: "memory")
#define PG8_WAIT_L(n) asm volatile("s_waitcnt lgkmcnt(" #n ")" ::: "memory")
#define PG8_BAR __builtin_amdgcn_s_barrier()
#define PG8_SCHED __builtin_amdgcn_sched_barrier(0)
    Unit cur, nxt; int ui = 0;
    if (!S.next(0, cur)) return;
    f32x4 acc[2][2][4][2];
#pragma unroll
    for (int a = 0; a < 2; ++a)
#pragma unroll
        for (int b = 0; b < 2; ++b)
#pragma unroll
            for (int m = 0; m < 4; ++m)
#pragma unroll
                for (int n = 0; n < 2; ++n) acc[a][b][m][n] = (f32x4){0.f, 0.f, 0.f, 0.f};
    bf16x8 At[4][2], B0[2][2], B1[2][2];
    const char* cA = cur.a; const char* cB = cur.b;
    PG8_STAGE(PG8_SB(0, 0), cB, voffB); PG8_STAGE(PG8_SA(0, 0), cA, voffA); PG8_STAGE(PG8_SB(0, 1), cB + hsB, voffB); PG8_STAGE(PG8_SA(0, 1), cA + hsA, voffA);
    if (wr == 1) PG8_BAR;
    PG8_WAIT_V(4); PG8_BAR;
    PG8_STAGE(PG8_SB(1, 0), cB + kstep, voffB); PG8_STAGE(PG8_SA(1, 0), cA + kstep, voffA); PG8_STAGE(PG8_SB(1, 1), cB + hsB + kstep, voffB);
    PG8_WAIT_V(6); PG8_BAR;
    for (;;) {
        const bool has_next = S.next(ui + 1, nxt);
        const char* nA = has_next ? nxt.a : cA; const char* nB = has_next ? nxt.b : cB;
        for (int t = 0; t < nt; t += 2) {
            const bool last = (t == nt - 2);
            if constexpr (Epi::MID) { if (t == 8 || t == 16) { int fr2 = fr, fq2 = fq; asm volatile("" : "+v"(fr2), "+v"(fq2)); E.mid(acc, cur, t == 16 ? 1 : 0, wr, wc, fr2, fq2); } }
            const char* a1 = cA + (size_t)(t + 1) * kstep;
            const char* a2 = last ? nA : cA + (size_t)(t + 2) * kstep; const char* b2 = last ? nB : cB + (size_t)(t + 2) * kstep;
            const char* a3 = a2 + kstep; const char* b3 = b2 + kstep;
            PG8_LDB(B0, 0, 0); PG8_SCHED; PG8_LDA(At, 0, 0); PG8_STAGE(PG8_SA(1, 1), a1 + hsA, voffA);
            PG8_WAIT_L(8); PG8_BAR; PG8_WAIT_L(0); PG8_MMA(0, 0, At, B0); PG8_BAR; PG8_SCHED;
            PG8_LDB(B1, 0, 1); PG8_STAGE(PG8_SB(0, 0), b2, voffB);
            PG8_BAR; PG8_WAIT_L(0); PG8_MMA(0, 1, At, B1); PG8_BAR;
            PG8_LDA(At, 0, 1); PG8_STAGE(PG8_SA(0, 0), a2, voffA);
            PG8_BAR; PG8_WAIT_L(0); PG8_MMA(1, 0, At, B0); PG8_BAR; PG8_SCHED;
            PG8_STAGE(PG8_SB(0, 1), b2 + hsB, voffB);
            PG8_WAIT_V(6); PG8_BAR; PG8_MMA(1, 1, At, B1); PG8_BAR;
            PG8_LDB(B0, 1, 0); PG8_SCHED; PG8_LDA(At, 1, 0); PG8_STAGE(PG8_SA(0, 1), a2 + hsA, voffA);
            PG8_WAIT_L(8); PG8_BAR; PG8_WAIT_L(0); PG8_MMA(0, 0, At, B0); PG8_BAR; PG8_SCHED;
            PG8_LDB(B1, 1, 1); PG8_STAGE(PG8_SB(1, 0), b3, voffB);
            PG8_BAR; PG8_WAIT_L(0); PG8_MMA(0, 1, At, B1); PG8_BAR;
            PG8_LDA(At, 1, 1); PG8_STAGE(PG8_SA(1, 0), a3, voffA);
            PG8_BAR; PG8_WAIT_L(0); PG8_MMA(1, 0, At, B0); PG8_BAR; PG8_SCHED;
            PG8_STAGE(PG8_SB(1, 1), b3 + hsB, voffB);
            PG8_WAIT_V(6); PG8_BAR; PG8_MMA(1, 1, At, B1); PG8_BAR;
        }
        { int fr2 = fr, fq2 = fq; asm volatile("" : "+v"(fr2), "+v"(fq2));
          E(acc, cur, wr, wc, fr2, fq2); }
        if (!has_next) break;
#pragma unroll
        for (int a = 0; a < 2; ++a)
#pragma unroll
            for (int b = 0; b < 2; ++b)
#pragma unroll
                for (int m = 0; m < 4; ++m)
#pragma unroll
                    for (int n = 0; n < 2; ++n) acc[a][b][m][n] = (f32x4){0.f, 0.f, 0.f, 0.f};
        cur = nxt; cA = nA; cB = nB; ++ui;
    }
    PG8_WAIT_V(0);
    if (wr == 0) PG8_BAR;
    PG8_BAR;
#undef PG8_SA
#undef PG8_SB
#undef PG8_STAGE
#undef PG8_LDA
#undef PG8_LDB
#undef PG8_MMA
#undef PG8_WAIT_V
#undef PG8_WAIT_L
#undef PG8_BAR
#undef PG8_SCHED
}
}
using pg8::Unit;
typedef const f32x4 (&AccRef)[2][2][4][2];

struct EpiSwiglu {
    static constexpr bool PERM = true, MID = false;
    bf16_t* ACT;
    DI void operator()(AccRef acc, const Unit& u, int wr, int wc, int fr, int fq) const {
        const int row0 = u.pm * 256 + wr * 64 + fr, col0 = u.pn * 128 + wc * 32 + 8 * fq;
#pragma unroll
        for (int ai = 0; ai < 2; ++ai)
#pragma unroll
            for (int m = 0; m < 4; ++m) {
                f32x4 o[2];
#pragma unroll
                for (int n = 0; n < 2; ++n)
#pragma unroll
                    for (int i = 0; i < 4; ++i) { const float g = acc[ai][0][m][n][i]; o[n][i] = g * sigmoidf_(g) * acc[ai][1][m][n][i]; }
                store8(ACT + (size_t)(row0 + ai * 128 + m * 16) * DFF + col0, o[0], o[1]);
            }
    }
};
struct EpiResid {
    static constexpr bool PERM = false, MID = false;
    float* H; const float* modl; int gidx; float fac; int atomic;
    DI void operator()(AccRef acc, const Unit& u, int wr, int wc, int fr, int fq) const {
        const int mrow = (u.pm % 9 == 0) ? 8 : u.pm / 9;
        const float* gate = modl + (size_t)mrow * 9216 + gidx * 1024;
        const int row0 = u.pm * 256 + wr * 64 + fr, col0 = u.pn * 256 + wc * 32 + 4 * fq;
        f32x4 gv[2][2];
#pragma unroll
        for (int bj = 0; bj < 2; ++bj)
#pragma unroll
            for (int n = 0; n < 2; ++n) gv[bj][n] = *(const f32x4*)(gate + col0 + bj * 128 + n * 16) * fac;
#pragma unroll
        for (int ai = 0; ai < 2; ++ai)
#pragma unroll
            for (int m = 0; m < 4; ++m) {
                float* rowp = H + (size_t)(row0 + ai * 128 + m * 16) * DM + col0;
#pragma unroll
                for (int bj = 0; bj < 2; ++bj)
#pragma unroll
                    for (int n = 0; n < 2; ++n) { f32x4* p = (f32x4*)(rowp + bj * 128 + n * 16); const f32x4 v = gv[bj][n] * acc[ai][bj][m][n];
                        if (atomic) { unsafeAtomicAdd((float*)p, v[0]); unsafeAtomicAdd((float*)p + 1, v[1]); unsafeAtomicAdd((float*)p + 2, v[2]); unsafeAtomicAdd((float*)p + 3, v[3]); }
                        else *p = *p + v; }
            }
    }
};
struct EpiIn {
    static constexpr bool PERM = true, MID = false;
    bf16_t *QD, *KD, *PQ, *CKV, *G, *KM, *VTD, *FT, *FTC; float *rsq, *rskv; const float *RD, *RM;
    DI void operator()(AccRef acc, const Unit& u, int wr, int wc, int fr, int fq) const {
        if (u.s == 0) {
            const int pn = u.pn, tt = u.pm % 9; const bool lat = tt != 0;
            const int rl0 = wr * 64 + fr;
            if (pn < 4) {
                bf16_t* dst = (pn < 2) ? QD : KD;
                const int colb = (pn & 1) * 256 + wc * 32 + 8 * fq, sel = wc & 1; const bool first = (fq >> 1) == 0;
#pragma unroll
                for (int ai = 0; ai < 2; ++ai)
#pragma unroll
                    for (int m = 0; m < 4; ++m) {
                        const int rl = rl0 + ai * 128 + m * 16; const size_t row = (size_t)u.pm * 256 + rl; const int pos = (tt - 1) * 256 + rl;
#pragma unroll
                        for (int bj = 0; bj < 2; ++bj) {
                            f32x4 v0 = acc[ai][bj][m][0], v1 = acc[ai][bj][m][1];
                            if (lat) rope8(v0, v1, RD + ((size_t)pos * 32 + sel * 16 + 8 * (fq & 1)) * 2, first, 32);
                            store8(dst + row * 512 + colb + bj * 128, v0, v1);
                            asm volatile("" ::: "memory");
                        }
                    }
            } else if (pn < 6) {
#pragma unroll
                for (int ai = 0; ai < 2; ++ai)
#pragma unroll
                    for (int m = 0; m < 4; ++m) {
                        const int rl = rl0 + ai * 128 + m * 16; const size_t row = (size_t)u.pm * 256 + rl; const int pos = (tt - 1) * 256 + rl;
#pragma unroll
                        for (int bj = 0; bj < 2; ++bj) {
                            f32x4 v0 = acc[ai][bj][m][0], v1 = acc[ai][bj][m][1];
                            const int c = (pn - 4) * 256 + bj * 128 + wc * 32;
                            if (c < 384) {
                                float ss = v0[0] * v0[0] + v0[1] * v0[1] + v0[2] * v0[2] + v0[3] * v0[3] + v1[0] * v1[0] + v1[1] * v1[1] + v1[2] * v1[2] + v1[3] * v1[3];
                                ss += __shfl_xor(ss, 16); ss += __shfl_xor(ss, 32);
                                if (fq == 0) atomicAdd(rsq + row, ss);
                                store8(PQ + row * YW + c + 8 * fq, v0, v1);
                            } else if (c == 384) {
                                if (lat) rope8(v0, v1, RM + ((size_t)pos * 16 + (fq >> 1) * 8) * 2, (fq & 1) == 0, 16);
#pragma unroll
                                for (int h = 0; h < 8; ++h) store8(KM + row * 768 + h * 96 + 64 + 8 * fq, v0, v1);
                            }
                            asm volatile("" ::: "memory");
                        }
                    }
            } else if (pn == 6) {
#pragma unroll
                for (int ai = 0; ai < 2; ++ai)
#pragma unroll
                    for (int m = 0; m < 4; ++m) {
                        const size_t row = (size_t)u.pm * 256 + rl0 + ai * 128 + m * 16;
#pragma unroll
                        for (int bj = 0; bj < 2; ++bj) {
                            const f32x4 v0 = acc[ai][bj][m][0], v1 = acc[ai][bj][m][1];
                            float ss = v0[0] * v0[0] + v0[1] * v0[1] + v0[2] * v0[2] + v0[3] * v0[3] + v1[0] * v1[0] + v1[1] * v1[1] + v1[2] * v1[2] + v1[3] * v1[3];
                            ss += __shfl_xor(ss, 16); ss += __shfl_xor(ss, 32);
                            if (fq == 0) atomicAdd(rskv + row, ss);
                            store8(CKV + row * YW + bj * 128 + wc * 32 + 8 * fq, v0, v1);
                            asm volatile("" ::: "memory");
                        }
                    }
            } else {
                const int colb = (pn - 7) * 256 + wc * 32 + 8 * fq;
#pragma unroll
                for (int ai = 0; ai < 2; ++ai)
#pragma unroll
                    for (int m = 0; m < 4; ++m) {
                        const size_t row = (size_t)u.pm * 256 + rl0 + ai * 128 + m * 16;
#pragma unroll
                        for (int bj = 0; bj < 2; ++bj) {
                            f32x4 v0 = acc[ai][bj][m][0], v1 = acc[ai][bj][m][1];
#pragma unroll
                            for (int i = 0; i < 4; ++i) { v0[i] = sigmoidf_(v0[i]); v1[i] = sigmoidf_(v1[i]); }
                            store8(G + row * 3072 + colb + bj * 128, v0, v1);
                        }
                    }
            }
        } else {
            const int b = u.pn / 9, tt = u.pn % 9, cl = wc * 32 + 8 * fq;
#pragma unroll
            for (int ai = 0; ai < 2; ++ai)
#pragma unroll
                for (int m = 0; m < 4; ++m) {
                    const int r = u.pm * 256 + ai * 128 + wr * 64 + m * 16 + fr;
                    bf16_t* dst;
                    if (u.s == 1) dst = VTD + ((size_t)(b * 4 + (r >> 7)) * 128 + (r & 127)) * TPB + tt * 256;
                    else {
                        const int g = r >> 8, part = (r >> 7) & 1, mm = r & 127;
                        dst = (tt == 0) ? FTC + ((size_t)(b * 512 + g * 128 + mm) * 512 + part * 256)
                                        : FT + ((size_t)(b * 512 + g * 128 + mm) * 4096 + part * 2048 + (tt - 1) * 256);
                    }
#pragma unroll
                    for (int bj = 0; bj < 2; ++bj) store8(dst + bj * 128 + cl, acc[ai][bj][m][0], acc[ai][bj][m][1]);
                }
        }
    }
};
struct EpiUp {
    static constexpr bool PERM = true, MID = false;
    bf16_t *QM, *KM, *VTM; const float *rsq, *rskv, *RM; int mode;
    DI void operator()(AccRef acc, const Unit& u, int wr, int wc, int fr, int fq) const {
        if (mode == 0) {
            const int tt = u.pm % 9; const bool lat = tt != 0; const int rl0 = wr * 64 + fr;
#pragma unroll
            for (int ai = 0; ai < 2; ++ai)
#pragma unroll
                for (int m = 0; m < 4; ++m) {
                    const int rl = rl0 + ai * 128 + m * 16; const size_t row = (size_t)u.pm * 256 + rl; const int pos = (tt - 1) * 256 + rl;
                    const float rs = __builtin_amdgcn_rsqf(rsq[row] * (1.0f / 384.0f) + RMS_EPS);
#pragma unroll
                    for (int bj = 0; bj < 2; ++bj) {
                        const int c = u.pn * 256 + bj * 128 + wc * 32;
                        f32x4 v0 = acc[ai][bj][m][0] * rs, v1 = acc[ai][bj][m][1] * rs;
                        if (((c >> 5) % 3) == 2 && lat) rope8(v0, v1, RM + ((size_t)pos * 16 + (fq >> 1) * 8) * 2, (fq & 1) == 0, 16);
                        store8(QM + row * 768 + c + 8 * fq, v0, v1);
                    }
                    asm volatile("" ::: "memory");
                }
        } else if (u.s == 0) {
#pragma unroll
            for (int ai = 0; ai < 2; ++ai)
#pragma unroll
                for (int m = 0; m < 4; ++m) {
                    const size_t row = (size_t)u.pm * 256 + wr * 64 + fr + ai * 128 + m * 16;
                    const float rs = __builtin_amdgcn_rsqf(rskv[row] * (1.0f / 256.0f) + RMS_EPS);
#pragma unroll
                    for (int bj = 0; bj < 2; ++bj) {
                        const int c = u.pn * 256 + bj * 128 + wc * 32 + 8 * fq;
                        store8(KM + row * 768 + (c >> 6) * 96 + (c & 63), acc[ai][bj][m][0] * rs, acc[ai][bj][m][1] * rs);
                    }
                    asm volatile("" ::: "memory");
                }
        } else {
            const int b = u.pn / 9, tt = u.pn % 9, cl = wc * 32 + 8 * fq;
#pragma unroll
            for (int bj = 0; bj < 2; ++bj) {
                f32x4 rs[2];
#pragma unroll
                for (int n = 0; n < 2; ++n) {
                    const f32x4 q = *(const f32x4*)(rskv + (size_t)u.pn * 256 + bj * 128 + cl + 4 * n);
#pragma unroll
                    for (int i = 0; i < 4; ++i) rs[n][i] = __builtin_amdgcn_rsqf(q[i] * (1.0f / 256.0f) + RMS_EPS);
                }
#pragma unroll
                for (int ai = 0; ai < 2; ++ai)
#pragma unroll
                    for (int m = 0; m < 4; ++m) {
                        const int r = u.pm * 256 + ai * 128 + wr * 64 + m * 16 + fr;
                        bf16_t* dst = VTM + ((size_t)(b * 8 + (r >> 6)) * 64 + (r & 63)) * TPB + tt * 256;
                        store8(dst + bj * 128 + cl, acc[ai][bj][m][0] * rs[0], acc[ai][bj][m][1] * rs[1]);
                    }
                asm volatile("" ::: "memory");
            }
        }
    }
};
struct EpiF2 {
    static constexpr bool PERM = true, MID = false;
    bf16_t* Y; int ctx;
    DI void operator()(AccRef acc, const Unit& u, int wr, int wc, int fr, int fq) const {
        const int q = u.pm >> 3;
        const size_t rowb = ctx ? (size_t)u.pm * TPB : (size_t)(q >> 1) * TPB + 256 + (u.pm & 7) * 256;
        const int colb = 1024 + (ctx ? 0 : (q & 1) * 512) + u.pn * 256 + wc * 32 + 8 * fq;
#pragma unroll
        for (int ai = 0; ai < 2; ++ai)
#pragma unroll
            for (int m = 0; m < 4; ++m) {
                const size_t row = rowb + wr * 64 + fr + ai * 128 + m * 16;
#pragma unroll
                for (int bj = 0; bj < 2; ++bj) {
                    store8(Y + row * YW + colb + bj * 128, acc[ai][bj][m][0], acc[ai][bj][m][1]);
                    if (ctx) *(u32x4*)(Y + row * YW + colb + bj * 128 + 512) = (u32x4){0u, 0u, 0u, 0u};
                }
            }
    }
};
struct EpiMerge {
    static constexpr bool PERM = true, MID = true;
    bf16_t* MG; const bf16_t* G;
    DI void mid(f32x4 (&acc)[2][2][4][2], const Unit& u, int which, int wr, int wc, int fr, int fq) const {
#pragma unroll
        for (int ai = 0; ai < 2; ++ai)
#pragma unroll
            for (int m = 0; m < 4; ++m) {
                const size_t row = (size_t)u.pm * 256 + wr * 64 + fr + ai * 128 + m * 16;
#pragma unroll
                for (int bj = 0; bj < 2; ++bj) {
                    const int c = u.pn * 256 + bj * 128 + wc * 32 + 8 * fq;
                    f32x4 a0, a1, b0, b1; load8(G + row * 3072 + which * 1024 + c, a0, a1); load8(G + row * 3072 + (which + 1) * 1024 + c, b0, b1);
#pragma unroll
                    for (int i = 0; i < 4; ++i) { acc[ai][bj][m][0][i] *= a0[i] * __builtin_amdgcn_rcpf(b0[i]); acc[ai][bj][m][1][i] *= a1[i] * __builtin_amdgcn_rcpf(b1[i]); }
                }
                asm volatile("" ::: "memory");
            }
    }
    DI void operator()(AccRef acc, const Unit& u, int wr, int wc, int fr, int fq) const {
#pragma unroll
        for (int ai = 0; ai < 2; ++ai)
#pragma unroll
            for (int m = 0; m < 4; ++m) {
                const size_t row = (size_t)u.pm * 256 + wr * 64 + fr + ai * 128 + m * 16;
#pragma unroll
                for (int bj = 0; bj < 2; ++bj) {
                    const int c = u.pn * 256 + bj * 128 + wc * 32 + 8 * fq;
                    f32x4 g0, g1; load8(G + row * 3072 + 2048 + c, g0, g1);
                    store8(MG + row * 1024 + c, g0 * acc[ai][bj][m][0], g1 * acc[ai][bj][m][1]);
                }
            }
    }
};

#define MFMA32(a, b, c) __builtin_amdgcn_mfma_f32_32x32x16_bf16((a), (b), (c), 0, 0, 0)
template <int D, int DV, bool DIFF>
DI void attn_item(LAS unsigned char* lds, const bf16_t* Qb, int ldq, const bf16_t* Kb, int ldk, const bf16_t* VT, int nkeys, int nq,
                  bf16_t* Yb, float lam, float outfac, const float* subg) {
    constexpr int KROW = (DIFF ? 256 : 192) + 16, VROW = 144, KBYTES = 64 * KROW, VBYTES = DV * VROW, STAGE = KBYTES + VBYTES;
    constexpr int KCH = DIFF ? 16 : 12, NKC = 64 * KCH, NVC = DV * 8, NKK = D / 16, NDVB = DV / 32;
    int tid = threadIdx.x; asm volatile("" : "+v"(tid));
    const int wave = __builtin_amdgcn_readfirstlane(tid >> 6), lane = tid & 63, l32 = lane & 31, half = lane >> 5;
    const float cs = (DIFF ? 0.125f : 0.10206207261596575f) * 1.4426950408889634f;
    const bool active = DIFF ? true : (wave * 64 < nq);
    bf16x8 qf[2][DIFF ? 1 : NKK];
    const LAS unsigned char* qlds = lds + 2 * STAGE + (wave * 32 + l32) * KROW + half * 16;
    if (DIFF) {
#pragma unroll
        for (int i = 0; i < 8; ++i) { const int ch = tid + i * NT, r = ch >> 4, cc = ch & 15;
            *(LAS u32x4*)(lds + 2 * STAGE + r * KROW + cc * 16) = *(const u32x4*)(Qb + (size_t)r * ldq + cc * 8); }
    } else {
#pragma unroll
        for (int s = 0; s < 2; ++s)
#pragma unroll
            for (int kk = 0; kk < NKK; ++kk) {
                const int qr = wave * 64 + s * 32 + l32, qc = kk * 16 + half * 8;
                qf[s][DIFF ? 0 : kk] = active ? *(const bf16x8*)(Qb + (size_t)qr * ldq + qc) : (bf16x8){0, 0, 0, 0, 0, 0, 0, 0};
            }
    }
    f32x16 O[2][NDVB];
#pragma unroll
    for (int s = 0; s < 2; ++s)
#pragma unroll
        for (int d = 0; d < NDVB; ++d)
#pragma unroll
            for (int i = 0; i < 16; ++i) O[s][d][i] = 0.f;
    float mrun[2] = {-1e30f, -1e30f}, lsum[2] = {0.f, 0.f};
    const int nt = nkeys / 64;
    u32x4 kr[2], vr[2];
    const int kc0 = tid, kc1 = tid + NT;
    const bool k1ok = kc1 < NKC, v1ok = (tid + NT) < NVC;
    const int krow0 = kc0 / KCH, kcc0 = kc0 % KCH, krow1 = kc1 / KCH, kcc1 = kc1 % KCH;
    const int vrow0 = tid >> 3, vcc0 = tid & 7, vrow1 = (tid + NT) >> 3;
#define ATT_LOAD(t) do { const int key0 = (t) * 64; \
        kr[0] = *(const u32x4*)(Kb + (size_t)(key0 + krow0) * ldk + kcc0 * 8); \
        if (k1ok) kr[1] = *(const u32x4*)(Kb + (size_t)(key0 + krow1) * ldk + kcc1 * 8); \
        vr[0] = *(const u32x4*)(VT + (size_t)vrow0 * TPB + key0 + vcc0 * 8); \
        if (v1ok) vr[1] = *(const u32x4*)(VT + (size_t)vrow1 * TPB + key0 + vcc0 * 8); } while (0)
#define ATT_WRITE(st) do { LAS unsigned char* sb = lds + (st) * STAGE; \
        *(LAS u32x4*)(sb + krow0 * KROW + kcc0 * 16) = kr[0]; \
        if (k1ok) *(LAS u32x4*)(sb + krow1 * KROW + kcc1 * 16) = kr[1]; \
        *(LAS u32x4*)(sb + KBYTES + vrow0 * VROW + vcc0 * 16) = vr[0]; \
        if (v1ok) *(LAS u32x4*)(sb + KBYTES + vrow1 * VROW + vcc0 * 16) = vr[1]; } while (0)
    ATT_LOAD(0); ATT_WRITE(0); __syncthreads();
    for (int t = 0; t < nt; ++t) {
        if (t + 1 < nt) ATT_LOAD(t + 1);
        if (active) {
            const LAS unsigned char* sb = lds + (t & 1) * STAGE;
#pragma unroll
            for (int kb = 0; kb < 2; ++kb) {
                bf16x8 P[2][2];
                f32x16 S[2];
                if (!DIFF) {
#pragma unroll
                    for (int s = 0; s < 2; ++s)
#pragma unroll
                        for (int i = 0; i < 16; ++i) S[s][i] = 0.f;
#pragma unroll
                    for (int kk = 0; kk < NKK; ++kk) {
                        const bf16x8 kf = *(const LAS bf16x8*)(sb + (kb * 32 + l32) * KROW + (kk * 16 + half * 8) * 2);
                        S[0] = MFMA32(kf, qf[0][DIFF ? 0 : kk], S[0]); S[1] = MFMA32(kf, qf[1][DIFF ? 0 : kk], S[1]);
                    }
                }
#pragma unroll
                for (int s = 0; s < 2; ++s) {
                    if (DIFF) {
#pragma unroll
                        for (int i = 0; i < 16; ++i) S[s][i] = 0.f;
#pragma unroll
                        for (int kk = 0; kk < NKK; ++kk) {
                            const bf16x8 kf = *(const LAS bf16x8*)(sb + (kb * 32 + l32) * KROW + (s * 64 + kk * 16 + half * 8) * 2);
                            const bf16x8 qq = *(const LAS bf16x8*)(qlds + (s * 64 + kk * 16) * 2);
                            S[s] = MFMA32(kf, qq, S[s]);
                        }
                    }
                    float mx = S[s][0];
#pragma unroll
                    for (int i = 1; i < 16; ++i) mx = fmaxf(mx, S[s][i]);
                    mx = fmaxf(mx, __shfl_xor(mx, 32));
                    const float mt2 = mx * cs;
                    if (__builtin_amdgcn_ballot_w64(mt2 > mrun[s] + 8.0f) != 0ull) {
                        const float mnew = fmaxf(mrun[s], mt2), alpha = fast_exp2(mrun[s] - mnew);
                        lsum[s] *= alpha;
#pragma unroll
                        for (int d = 0; d < NDVB; ++d)
#pragma unroll
                            for (int i = 0; i < 16; ++i) O[s][d][i] *= alpha;
                        mrun[s] = mnew;
                    }
                    float ls = 0.f;
#pragma unroll
                    for (int i = 0; i < 16; ++i) { S[s][i] = fast_exp2(S[s][i] * cs - mrun[s]); ls += S[s][i]; }
                    lsum[s] += ls;
#pragma unroll
                    for (int k2 = 0; k2 < 2; ++k2) {
                        u32x4 w = {pk2(S[s][8 * k2], S[s][8 * k2 + 1]), pk2(S[s][8 * k2 + 2], S[s][8 * k2 + 3]), pk2(S[s][8 * k2 + 4], S[s][8 * k2 + 5]), pk2(S[s][8 * k2 + 6], S[s][8 * k2 + 7])};
                        P[s][k2] = __builtin_bit_cast(bf16x8, w);
                    }
                    if (DIFF) asm volatile("" ::: "memory");
                }
#pragma unroll
                for (int d = 0; d < NDVB; ++d)
#pragma unroll
                    for (int k2 = 0; k2 < 2; ++k2) {
                        const LAS unsigned char* va = sb + KBYTES + (d * 32 + l32) * VROW + (kb * 32 + k2 * 16 + half * 4) * 2;
                        const u32x2 lo = *(const LAS u32x2*)va, hi = *(const LAS u32x2*)(va + 16);
                        const u32x4 w = {lo.x, lo.y, hi.x, hi.y};
                        const bf16x8 vf = __builtin_bit_cast(bf16x8, w);
                        O[0][d] = MFMA32(vf, P[0][k2], O[0][d]); O[1][d] = MFMA32(vf, P[1][k2], O[1][d]);
                        if (DIFF) asm volatile("" ::: "memory");
                    }
            }
        }
        if (t + 1 < nt) ATT_WRITE((t + 1) & 1);
        __syncthreads();
    }
#undef ATT_LOAD
#undef ATT_WRITE
    if (!active) return;
    int l32e = l32, halfe = half; asm volatile("" : "+v"(l32e), "+v"(halfe));
    float inv[2];
#pragma unroll
    for (int s = 0; s < 2; ++s) { const float l = lsum[s] + __shfl_xor(lsum[s], 32); inv[s] = 1.0f / l; }
    if (DIFF) {
        float ss = 0.f;
#pragma unroll
        for (int d = 0; d < NDVB; ++d)
#pragma unroll
            for (int i = 0; i < 16; ++i) { const float o = O[0][d][i] * inv[0] - lam * (O[1][d][i] * inv[1]); O[0][d][i] = o; ss += o * o; }
        ss += __shfl_xor(ss, 32);
        const float rs = __builtin_amdgcn_rsqf(ss * (1.0f / 128.0f) + RMS_EPS) * outfac;
        bf16_t* yr = Yb + (size_t)(wave * 32 + l32e) * YW;
#pragma unroll
        for (int d = 0; d < NDVB; ++d)
#pragma unroll
            for (int g4 = 0; g4 < 4; ++g4) {
                const int dv = d * 32 + g4 * 8 + halfe * 4;
                const f32x4 gg = *(const f32x4*)(subg + dv);
                u32x2 w = {pk2(O[0][d][4 * g4] * rs * gg[0], O[0][d][4 * g4 + 1] * rs * gg[1]), pk2(O[0][d][4 * g4 + 2] * rs * gg[2], O[0][d][4 * g4 + 3] * rs * gg[3])};
                *(u32x2*)(yr + dv) = w;
            }
    } else {
#pragma unroll
        for (int s = 0; s < 2; ++s) {
            bf16_t* yr = Yb + (size_t)(wave * 64 + s * 32 + l32e) * YW;
#pragma unroll
            for (int d = 0; d < NDVB; ++d)
#pragma unroll
                for (int g4 = 0; g4 < 4; ++g4) {
                    const int dv = d * 32 + g4 * 8 + halfe * 4;
                    u32x2 w = {pk2(O[s][d][4 * g4] * inv[s], O[s][d][4 * g4 + 1] * inv[s]), pk2(O[s][d][4 * g4 + 2] * inv[s], O[s][d][4 * g4 + 3] * inv[s])};
                    *(u32x2*)(yr + dv) = w;
                }
        }
    }
}

DI int mapcol(int kind, int n) {
    switch (kind) {
        case 1: { const int pn = n >> 8, r = n & 255; return r < 128 ? pn * 128 + r : DFF + pn * 128 + (r - 128); }
        case 2: return n < 1024 ? n : n < 1408 ? 1536 + (n - 1024) : n < 1440 ? 2176 + (n - 1408) : n < 1536 ? -1 : n < 1792 ? 1920 + (n - 1536) : 2720 + (n - 1792);
        case 3: return 1024 + n;
        case 4: return (n >> 6) * 128 + (n & 63);
        case 5: return (n >> 6) * 128 + 64 + (n & 63);
        default: return n;
    }
}
DI void prepT(LAS float* tile, bf16_t* dst, int ldd, const float* src, int lds_, int Kd, int Nd, int kind, const float* kscale, int& rot) {
    int tid = threadIdx.x; asm volatile("" : "+v"(tid));
    const int G = gridDim.x, ntk = Kd >> 6, ntiles = ntk * (Nd >> 7);
    for (int t = (int)((blockIdx.x + (unsigned)G - (unsigned)(rot % G)) % (unsigned)G); t < ntiles; t += G) {
        const int k0 = (t % ntk) << 6, n0 = (t / ntk) << 7;
        const int n4 = (tid & 31) * 4, sc = mapcol(kind, n0 + n4);
        f32x4 v[4];
#pragma unroll
        for (int ps = 0; ps < 4; ++ps) {
            const int kk = ps * 16 + (tid >> 5);
            v[ps] = sc >= 0 ? *(const f32x4*)(src + (size_t)(k0 + kk) * lds_ + sc) : (f32x4){0.f, 0.f, 0.f, 0.f};
            if (kscale) v[ps] *= kscale[k0 + kk];
        }
#pragma unroll
        for (int ps = 0; ps < 4; ++ps) {
            const int kk = ps * 16 + (tid >> 5);
#pragma unroll
            for (int i = 0; i < 4; ++i) tile[kk * 129 + n4 + i] = v[ps][i];
        }
        __syncthreads();
#pragma unroll
        for (int h = 0; h < 2; ++h) {
            const int ch = tid + h * NT, on = ch >> 3, kc = ch & 7;
            u32x4 w;
            w.x = pk2(tile[(kc * 8 + 0) * 129 + on], tile[(kc * 8 + 1) * 129 + on]); w.y = pk2(tile[(kc * 8 + 2) * 129 + on], tile[(kc * 8 + 3) * 129 + on]);
            w.z = pk2(tile[(kc * 8 + 4) * 129 + on], tile[(kc * 8 + 5) * 129 + on]); w.w = pk2(tile[(kc * 8 + 6) * 129 + on], tile[(kc * 8 + 7) * 129 + on]);
            *(u32x4*)(dst + (size_t)(n0 + on) * ldd + k0 + kc * 8) = w;
        }
        __syncthreads();
    }
    rot += ntiles;
}

DI void prologue(const Params& p, LAS unsigned char* lds) {
    int tid = threadIdx.x; asm volatile("" : "+v"(tid));
    const int G = gridDim.x, bid = blockIdx.x;
    const size_t gtid = (size_t)bid * NT + tid, gsz = (size_t)G * NT;
    unsigned char* ws = p.ws;
    {
        f32x4* H = (f32x4*)(ws + OFF_H);
        for (size_t i = gtid; i < (size_t)T * 256; i += gsz) {
            const int t = (int)(i >> 8), c4 = (int)(i & 255), b = t / TPB, r = t - b * TPB;
            H[i] = r < CTX ? ((const f32x4*)p.ctx)[((size_t)b * CTX + r) * 256 + c4] : ((const f32x4*)p.x)[((size_t)b * SEQ + (r - CTX)) * 256 + c4];
        }
    }
    {
        float* RD = (float*)(ws + OFF_ROPED); float* RM = (float*)(ws + OFF_ROPEM);
        for (size_t i = gtid; i < (size_t)2048 * 32; i += gsz) {
            const int pos = (int)(i >> 5), e = (int)(i & 31), sel = e >> 4, j = e & 15;
            const float fr = __powf(10000.f, -(float)j / 16.f), ang = (float)(sel ? (pos & 63) : (pos >> 6)) * fr, rev = ang * 0.15915494309189535f;
            RD[2 * i] = __builtin_amdgcn_cosf(rev); RD[2 * i + 1] = __builtin_amdgcn_sinf(rev);
        }
        for (size_t i = gtid; i < (size_t)2048 * 16; i += gsz) {
            const int pos = (int)(i >> 4), e = (int)(i & 15), sel = e >> 3, j = e & 7;
            const float fr = __powf(10000.f, -(float)j / 8.f), ang = (float)(sel ? (pos & 63) : (pos >> 6)) * fr, rev = ang * 0.15915494309189535f;
            RM[2 * i] = __builtin_amdgcn_cosf(rev); RM[2 * i + 1] = __builtin_amdgcn_sinf(rev);
        }
    }
    {
        u32x4* DL = (u32x4*)(ws + OFF_DFTL);
        for (size_t i = gtid; i < (size_t)2048 * 512; i += gsz) {
            const int k = (int)(i >> 9), c8 = (int)(i & 511) * 8, part = c8 >> 11, n0 = c8 & 2047;
            float v[8];
#pragma unroll
            for (int j = 0; j < 8; ++j) { const float fr = (float)((k * (n0 + j)) & 2047) * (1.0f / 2048.0f);
                v[j] = (part ? -__builtin_amdgcn_sinf(fr) : __builtin_amdgcn_cosf(fr)) * 0.022097086912079608f; }
            DL[i] = (u32x4){pk2(v[0], v[1]), pk2(v[2], v[3]), pk2(v[4], v[5]), pk2(v[6], v[7])};
        }
        u32x4* DC = (u32x4*)(ws + OFF_DFTC);
        for (size_t i = gtid; i < (size_t)256 * 64; i += gsz) {
            const int k = (int)(i >> 6), c8 = (int)(i & 63) * 8, part = c8 >> 8, n0 = c8 & 255;
            float v[8];
#pragma unroll
            for (int j = 0; j < 8; ++j) { const float fr = (float)((k * (n0 + j)) & 255) * (1.0f / 256.0f);
                v[j] = (part ? -__builtin_amdgcn_sinf(fr) : __builtin_amdgcn_cosf(fr)) * 0.0625f; }
            DC[i] = (u32x4){pk2(v[0], v[1]), pk2(v[2], v[3]), pk2(v[4], v[5]), pk2(v[6], v[7])};
        }
    }
    if (bid == 0 && tid < DEPTH) {
        const float* dl = p.diff_lambda + tid * 4 * 64; float a = 0.f, b = 0.f;
        for (int i = 0; i < 64; ++i) { a += dl[i] * dl[64 + i]; b += dl[128 + i] * dl[192 + i]; }
        const float lam_init = 0.8f - 0.6f * expf(-0.3f * (float)tid);
        ((float*)(ws + OFF_LAM))[tid] = expf(a) - expf(b) + lam_init;
        ((float*)(ws + OFF_LAM))[4 + tid] = 1.0f - lam_init;
    }
    {
        LAS float* sc = (LAS float*)lds;
        LAS float* red = (LAS float*)(lds + 40960);
        for (int i = tid; i < 9 * 1024; i += NT) { const float v = i < 8192 ? p.c[i] : p.c_ctx[i - 8192]; sc[i] = v * sigmoidf_(v); }
        __syncthreads();
        float* MOD = (float*)(ws + OFF_MOD);
        for (int it = bid; it < DEPTH * 144; it += G) {
            const int l = it / 144, n0 = (it % 144) * 64, col = tid & 63, kg = tid >> 6;
            const float* w = p.ada_w + (size_t)l * 1024 * 9216 + n0 + col;
            float a[9];
#pragma unroll
            for (int r = 0; r < 9; ++r) a[r] = 0.f;
            for (int k8 = kg * 128; k8 < kg * 128 + 128; k8 += 8) {
                float wv[8];
#pragma unroll
                for (int j = 0; j < 8; ++j) wv[j] = w[(size_t)(k8 + j) * 9216];
#pragma unroll
                for (int j = 0; j < 8; ++j)
#pragma unroll
                    for (int r = 0; r < 9; ++r) a[r] += sc[r * 1024 + k8 + j] * wv[j];
            }
#pragma unroll
            for (int r = 0; r < 9; ++r) red[(kg * 9 + r) * 64 + col] = a[r];
            __syncthreads();
            for (int o = tid; o < 576; o += NT) {
                const int r = o >> 6, cc = o & 63; float s = p.ada_b[l * 9216 + n0 + cc];
#pragma unroll
                for (int g = 0; g < 8; ++g) s += red[(g * 9 + r) * 64 + cc];
                MOD[((size_t)l * 9 + r) * 9216 + n0 + cc] = s;
            }
            __syncthreads();
        }
    }
    {
        LAS float* wt = (LAS float*)lds;
        LAS float* tc = (LAS float*)(lds + 16384);
        LAS bf16_t* ot = (LAS bf16_t*)(lds + 20480);
        for (int i = tid; i < 128; i += NT) { tc[i] = __builtin_amdgcn_cosf((float)i * (1.0f / 128.0f)); tc[128 + i] = __builtin_amdgcn_sinf((float)i * (1.0f / 128.0f)); }
        for (int it = bid; it < DEPTH * 4 * 32; it += G) {
            const int l = it >> 7, g = (it >> 5) & 3, k0 = (it & 31) * 32;
            __syncthreads();
            for (int i = tid; i < 32 * 128; i += NT) wt[i] = p.w_in[((size_t)l * 1024 + k0 + (i >> 7)) * INW + 2208 + g * 128 + (i & 127)];
            __syncthreads();
            const int pmi = tid & 255, part = pmi >> 7, m = pmi & 127, kh = tid >> 8;
            float a[16];
#pragma unroll
            for (int i = 0; i < 16; ++i) a[i] = 0.f;
            for (int c = 0; c < 128; ++c) {
                const float tv = tc[part * 128 + ((m * c) & 127)];
#pragma unroll
                for (int i = 0; i < 16; ++i) a[i] += wt[(2 * i + kh) * 128 + c] * tv;
            }
#pragma unroll
            for (int i = 0; i < 16; ++i) { const unsigned w = pk2(a[i] * 0.08838834764831845f, 0.f); ot[pmi * 32 + 2 * i + kh] = (bf16_t)(w & 0xffffu); }
            __syncthreads();
            bf16_t* AF = (bf16_t*)(ws + OFF_W) + (size_t)l * WE_END + WE_F;
            for (int ch = tid; ch < 1024; ch += NT) {
                const int r = ch >> 2, q = ch & 3;
                *(u32x4*)(AF + (size_t)(g * 256 + r) * 1024 + k0 + q * 8) = *(const LAS u32x4*)(ot + r * 32 + q * 8);
            }
        }
        __syncthreads();
    }
    {
        LAS float* tile = (LAS float*)lds; int rot = 0;
        for (int l = 0; l < DEPTH; ++l) {
            bf16_t* W = (bf16_t*)(ws + OFF_W) + (size_t)l * WE_END;
            for (int s = 0; s < 2; ++s) {
                prepT(tile, W + WE_W1 + (size_t)s * 5632 * 1024, 1024, p.ffn_w_in + ((size_t)l * 2 + s) * 1024 * 5632, 5632, 1024, 5632, 1, nullptr, rot);
                prepT(tile, W + WE_W2 + (size_t)s * 1024 * 2816, 2816, p.ffn_w_out + ((size_t)l * 2 + s) * 2816 * 1024, 1024, 2816, 1024, 0, nullptr, rot);
            }
            const float* win = p.w_in + (size_t)l * 1024 * INW;
            prepT(tile, W + WE_IN, 1024, win, INW, 1024, 4864, 2, nullptr, rot);
            prepT(tile, W + WE_V, 1024, win, INW, 1024, 512, 3, nullptr, rot);
            prepT(tile, W + WE_UQ, 384, p.mla_w_uq + (size_t)l * 384 * 768, 768, 384, 768, 0, p.mla_q_norm_g + l * 384, rot);
            prepT(tile, W + WE_UK, 2048, p.mla_w_ukv + (size_t)l * 256 * 1024, 1024, 256, 512, 4, p.mla_kv_norm_g + l * 256, rot);
            prepT(tile, W + WE_UV, 2048, p.mla_w_ukv + (size_t)l * 256 * 1024, 1024, 256, 512, 5, p.mla_kv_norm_g + l * 256, rot);
            prepT(tile, W + WE_B, 2048, p.w_bd + (size_t)l * 512 * 1024, 1024, 512, 1024, 0, nullptr, rot);
            prepT(tile, W + WE_B + 512, 2048, p.w_bm + (size_t)l * 512 * 1024, 1024, 512, 1024, 0, nullptr, rot);
            prepT(tile, W + WE_B + 1024, 2048, p.w_bf + (size_t)l * 512 * 1024, 1024, 512, 1024, 0, nullptr, rot);
            prepT(tile, W + WE_B + 1536, 2048, p.w_bf + (size_t)l * 512 * 1024, 1024, 512, 1024, 0, nullptr, rot);
            prepT(tile, W + WE_O, 1024, p.w_out + (size_t)l * 1024 * 1024, 1024, 1024, 1024, 0, nullptr, rot);
        }
    }
}

DI void norm_phase(const Params& p, const float* gain, const float* modl, int sh_i, int sc_i, bool zero, int rs) {
    int tid = threadIdx.x; asm volatile("" : "+v"(tid));
    const int lane = tid & 63, gw = blockIdx.x * 8 + (tid >> 6), nw = gridDim.x * 8;
    const float* H = (const float*)(p.ws + OFF_H); bf16_t* AN = (bf16_t*)(p.ws + OFF_AN);
    float* rsq = (float*)(p.ws + OFF_RSQ); float* rskv = (float*)(p.ws + OFF_RSKV);
    const int nrows = rs == 1 ? NB * SEQ : NB * CTX;
    f32x4 g[4];
#pragma unroll
    for (int j = 0; j < 4; ++j) g[j] = *(const f32x4*)(gain + (lane + 64 * j) * 4);
    for (int i0 = gw; i0 < nrows; i0 += nw * 4) {
        f32x4 v[4][4]; float ss[4]; int tr[4];
#pragma unroll
        for (int r = 0; r < 4; ++r) {
            const int i = (i0 + r * nw < nrows) ? i0 + r * nw : i0;
            tr[r] = rs == 1 ? (i >> 11) * TPB + CTX + (i & 2047) : (i >> 8) * TPB + (i & 255);
            const f32x4* hr = (const f32x4*)(H + (size_t)tr[r] * DM);
#pragma unroll
            for (int j = 0; j < 4; ++j) v[r][j] = hr[lane + 64 * j];
        }
#pragma unroll
        for (int r = 0; r < 4; ++r) {
            float s = 0.f;
#pragma unroll
            for (int j = 0; j < 4; ++j) s += v[r][j][0] * v[r][j][0] + v[r][j][1] * v[r][j][1] + v[r][j][2] * v[r][j][2] + v[r][j][3] * v[r][j][3];
            ss[r] = wave_sum(s);
        }
#pragma unroll
        for (int r = 0; r < 4; ++r) {
            if (i0 + r * nw < nrows) {
                const int t = tr[r];
                const float rsd = __builtin_amdgcn_rsqf(ss[r] * (1.0f / 1024.0f) + RMS_EPS);
                const int mrow = rs == 1 ? t / TPB : 8;
                const float* sh = modl + (size_t)mrow * 9216 + sh_i * 1024; const float* sc = modl + (size_t)mrow * 9216 + sc_i * 1024;
#pragma unroll
                for (int j = 0; j < 4; ++j) {
                    const int c = (lane + 64 * j) * 4;
                    const f32x4 s1 = *(const f32x4*)(sc + c), s0 = *(const f32x4*)(sh + c);
                    const f32x4 y = (v[r][j] * rsd * g[j]) * (s1 + 1.0f) + s0;
                    *(u32x2*)(AN + (size_t)t * DM + c) = (u32x2){pk2(y[0], y[1]), pk2(y[2], y[3])};
                }
                if (zero && lane == 0) { rsq[t] = 0.f; rskv[t] = 0.f; }
            }
        }
    }
}
DI void final_phase(const Params& p) {
    int tid = threadIdx.x; asm volatile("" : "+v"(tid));
    const int lane = tid & 63, gw = blockIdx.x * 8 + (tid >> 6), nw = gridDim.x * 8;
    const float* H = (const float*)(p.ws + OFF_H);
    for (int q = gw; q < NB * SEQ; q += nw) {
        const int b = q >> 11, n = q & 2047;
        const f32x4* hr = (const f32x4*)(H + ((size_t)b * TPB + CTX + n) * DM);
        f32x4 v[4]; float ss = 0.f;
#pragma unroll
        for (int j = 0; j < 4; ++j) { v[j] = hr[lane + 64 * j]; ss += v[j][0] * v[j][0] + v[j][1] * v[j][1] + v[j][2] * v[j][2] + v[j][3] * v[j][3]; }
        ss = wave_sum(ss);
        const float rs = __builtin_amdgcn_rsqf(ss * (1.0f / 1024.0f) + RMS_EPS);
#pragma unroll
        for (int j = 0; j < 4; ++j) { const int c = (lane + 64 * j) * 4; *(f32x4*)(p.out + (size_t)q * DM + c) = v[j] * rs * *(const f32x4*)(p.final_g + c); }
    }
}

#define XB_TMO      128
#define XB_XCNT(j)  (256  + 64 * (j))
#define XB_XSUB(j)  (1280 + 64 * (j))
#define XB_XGEN(j)  (2304 + 64 * (j))
#define XB_TOP      3328
#define XB_TOPGEN   3392
#define XB_SPIN_CAP (1u << 22)
DI unsigned xb_ld(unsigned* p) { return __hip_atomic_load(p, __ATOMIC_RELAXED, __HIP_MEMORY_SCOPE_AGENT); }
DI unsigned xb_add(unsigned* p, unsigned v) { return __hip_atomic_fetch_add(p, v, __ATOMIC_RELAXED, __HIP_MEMORY_SCOPE_AGENT); }
DI unsigned xb_xcc_id() { return (unsigned)__builtin_amdgcn_s_getreg((3 << 11) | 20) & 0xFu; }
#define XB_SPIN(cond, bar) do { unsigned _sp = 0; while (cond) { __builtin_amdgcn_s_sleep(1); \
    if ((++_sp & 255u) == 0u) { if (xb_ld(&(bar)[XB_TMO])) break; if (_sp > XB_SPIN_CAP) { atomicAdd(&(bar)[XB_TMO], 1u); break; } } } } while (0)
struct XcdBarrier { unsigned* bar; unsigned x; volatile LAS unsigned* st; };
DI XcdBarrier xcd_barrier_post(unsigned* bar, volatile LAS unsigned* st) {
    XcdBarrier b; b.bar = bar; b.x = xb_xcc_id(); b.st = st;
    if (threadIdx.x == 0) (void)xb_add(&bar[XB_XCNT(b.x)], 1u);
    return b;
}
DI void xcd_barrier_complete(unsigned* bar, unsigned x, unsigned& nloc, unsigned& nx) {
    const unsigned G = gridDim.x * gridDim.y * gridDim.z;
    unsigned sum, cnt, mine, sp = 0u;
    for (;;) {
        sum = 0u; cnt = 0u; mine = 0u;
#pragma unroll
        for (unsigned j = 0; j < 16; ++j) { const unsigned c = xb_ld(&bar[XB_XCNT(j)]); sum += c; cnt += (c > 0u) ? 1u : 0u; mine = (j == x) ? c : mine; }
        if (sum == G) break;
        __builtin_amdgcn_s_sleep(1);
        if ((++sp & 255u) == 0u) { if (xb_ld(&bar[XB_TMO])) break; if (sp > XB_SPIN_CAP) { atomicAdd(&bar[XB_TMO], 1u); break; } }
    }
    nloc = mine > 0u ? mine : 1u; nx = cnt > 0u ? cnt : 1u;
}
DI void xcd_barrier(const XcdBarrier& b) {
    asm volatile("s_waitcnt vmcnt(0)" ::: "memory");
    __syncthreads();
    if (threadIdx.x == 0) {
        unsigned* bar = b.bar;
        __builtin_amdgcn_s_waitcnt(0);
        unsigned nloc = b.st[0], nx = b.st[1];
        if (nloc == 0u) { xcd_barrier_complete(bar, b.x, nloc, nx); b.st[0] = nloc; b.st[1] = nx; }
        const unsigned old = xb_add(&bar[XB_XSUB(b.x)], 1u);
        const unsigned gen = old / nloc;
        if (old + 1u == (gen + 1u) * nloc) {
            __builtin_amdgcn_fence(__ATOMIC_RELEASE, "agent");
            asm volatile("s_waitcnt vmcnt(0)" ::: "memory");
            const unsigned og = xb_add(&bar[XB_TOP], 1u);
            const unsigned tg = og / nx;
            if (og + 1u == (tg + 1u) * nx) xb_add(&bar[XB_TOPGEN], 1u);
            else XB_SPIN(xb_ld(&bar[XB_TOPGEN]) == tg, bar);
            __builtin_amdgcn_fence(__ATOMIC_ACQUIRE, "agent");
            xb_add(&bar[XB_XGEN(b.x)], 1u);
            asm volatile("s_waitcnt vmcnt(0)" ::: "memory");
        } else {
            XB_SPIN(xb_ld(&bar[XB_XGEN(b.x)]) == gen, bar);
            __builtin_amdgcn_fence(__ATOMIC_ACQUIRE, "agent");
            asm volatile("s_waitcnt vmcnt(0)" ::: "memory");
        }
    }
    __syncthreads();
}

constexpr int NPH = 3 + 12 * DEPTH;
constexpr int CTX_LAST = 12 * (DEPTH - 1) + 5;
__global__ void __launch_bounds__(NT, 2) fwd_kernel(Params p) {
    extern __shared__ __attribute__((aligned(16))) unsigned char shm[];
    LAS unsigned char* lds = (LAS unsigned char*)shm;
    const int G = gridDim.x, bid = blockIdx.x;
    if (threadIdx.x < 4) ((LAS unsigned*)(lds + LDS_MAIN))[threadIdx.x] = 0u;
    __syncthreads();
    XcdBarrier xbar = xcd_barrier_post((unsigned*)(p.ws + OFF_BAR), (volatile LAS unsigned*)(lds + LDS_MAIN));
    for (int ph = p.ph_lo; ph < p.ph_hi; ++ph) {
        unsigned char* ws = p.ws; asm volatile("" : "+s"(ws));
        float* H = (float*)(ws + OFF_H); bf16_t* AN = (bf16_t*)(ws + OFF_AN); bf16_t* MG = AN;
        bf16_t* ACT = (bf16_t*)(ws + OFF_R1); bf16_t* GT = (bf16_t*)(ws + OFF_R1);
        bf16_t* QD = (bf16_t*)(ws + OFF_QD); bf16_t* KD = (bf16_t*)(ws + OFF_KD); bf16_t* VTD = (bf16_t*)(ws + OFF_VTD);
        bf16_t* FT = (bf16_t*)(ws + OFF_FT); bf16_t* FTC = (bf16_t*)(ws + OFF_FTC);
        bf16_t* QM = (bf16_t*)(ws + OFF_QM); bf16_t* KM = (bf16_t*)(ws + OFF_KM); bf16_t* VTM = (bf16_t*)(ws + OFF_VTM);
        bf16_t* Y = (bf16_t*)(ws + OFF_Y); bf16_t* PQ = (bf16_t*)(ws + OFF_PQ); bf16_t* CKV = (bf16_t*)(ws + OFF_CKV);
        float* RSQ = (float*)(ws + OFF_RSQ); float* RSKV = (float*)(ws + OFF_RSKV);
        const float* RD = (const float*)(ws + OFF_ROPED); const float* RM = (const float*)(ws + OFF_ROPEM);
        const float* LAM = (const float*)(ws + OFF_LAM);
        const bf16_t* DFTL = (const bf16_t*)(ws + OFF_DFTL); const bf16_t* DFTC = (const bf16_t*)(ws + OFF_DFTC);

        if (ph == 0) prologue(p, lds);
        else if (ph == NPH - 1) final_phase(p);
        else for (int w = 0; w < 2; ++w) {
            const int st = w ? ph - 2 : ph - 1;
            if (st < 0 || st > (w ? 12 * DEPTH - 1 : CTX_LAST)) continue;
            const int l = st / 12, sp = st % 12, rs = w ? 1 : 2, nP = w ? 64 : 8;
            const bool lat = w != 0;
            const int spc = (ph - 1 <= CTX_LAST) ? (ph - 1) % 12 : -1;
            const float* modl = (const float*)(ws + OFF_MOD) + (size_t)l * 9 * 9216;
            const bf16_t* W = (const bf16_t*)(ws + OFF_W) + (size_t)l * WE_END;
            pg8::Sched S; S.ns = 1; S.G = G; S.c = bid; S.rep = 1; S.za = 0; S.zb = 0; S.nb = 0; S.skip = 0;
            if (sp == 0 || sp == 3 || sp == 9) {
                const int ni = sp == 0 ? 0 : sp == 3 ? 1 : 2;
                norm_phase(p, p.norm_g + ((size_t)l * 3 + ni) * DM, modl, 3 * ni, 3 * ni + 1, sp == 3, rs);
            } else if (sp == 1 || sp == 10) {
                const int s = sp == 1 ? 0 : 1;
                S.s0 = pg8::mksub(AN, W + WE_W1 + (size_t)s * 5632 * 1024, nP, 22, 1024, 1024); S.s0.mapM = rs;
                if (lat && (spc == 2 || spc == 11)) { S.nb = 32; S.skip = 3; }
                EpiSwiglu E{ACT};
                pg8::gemm_phase(lds, 1024, 1024, 1024, S, E);
            } else if (sp == 2 || sp == 11) {
                const int s = sp == 2 ? 0 : 1;
                S.s0 = pg8::mksub(ACT, W + WE_W2 + (size_t)s * 1024 * 2816, nP, 4, 2816, 2816); S.s0.mapM = rs;
                EpiResid E{H, modl, s == 0 ? 2 : 8, 0.5f, 0};
                pg8::gemm_phase(lds, 2816, 2816, 2816, S, E);
            } else if (sp == 4) {
                S.ns = 3;
                S.s0 = pg8::mksub(AN, W + WE_IN, nP, 19, 1024, 1024); S.s0.mapM = rs;
                S.s1 = pg8::mksub(W + WE_V, AN, 2, nP, 1024, 1024); S.s1.mapN = rs;
                S.s2 = pg8::mksub(W + WE_F, AN, 4, nP, 1024, 1024); S.s2.mapN = rs;
                EpiIn E{QD, KD, PQ, CKV, GT, KM, VTD, FT, FTC, RSQ, RSKV, RD, RM};
                pg8::gemm_phase(lds, 1024, 1024, 1024, S, E);
            } else if (sp == 5) {
                for (int cx = 0; cx < 2; ++cx) {
                    const int coff = lat ? (cx ? 40 : 0) : (cx ? 88 : 64);
                    S.ns = cx ? 2 : 1; S.c = (bid + G - coff) % G;
                    S.s0 = cx ? pg8::mksub(CKV, W + WE_UK, nP, 2, YW, 2048) : pg8::mksub(PQ, W + WE_UQ, nP, 3, YW, 384); S.s0.mapM = rs;
                    S.s1 = pg8::mksub(W + WE_UV, CKV, 2, nP, 2048, YW); S.s1.mapN = rs;
                    EpiUp E{QM, KM, VTM, RSQ, RSKV, RM, cx};
                    pg8::gemm_phase(lds, cx ? 256 : 384, cx ? 2048 : YW, cx ? 2048 : 384, S, E);
                }
            } else if (sp == 6) {
                const float lam = LAM[l], outfac = LAM[4 + l];
                for (int i0 = (lat ? 0 : 256) + bid; i0 < (lat ? 256 : 288); i0 += G) {
                    const int it = lat ? ((G == 256) ? ((i0 & 7) * 32 + (i0 >> 3)) : i0) : i0 - 256;
                    const int b = lat ? it >> 5 : it >> 2, h = lat ? (it >> 3) & 3 : it & 3, qt = it & 7;
                    const size_t rb = (size_t)b * TPB, r0 = lat ? rb + CTX + qt * 256 : rb;
                    attn_item<64, 128, true>(lds, QD + r0 * 512 + h * 128, 512, KD + rb * 512 + h * 128, 512, VTD + (size_t)(b * 4 + h) * 128 * TPB, lat ? TPB : CTX, 256,
                                             Y + r0 * YW + h * 128, lam, outfac, p.diff_subln_g + l * 128);
                }
                for (int i0 = (lat ? bid : 256 + (bid + G - 32) % G); i0 < (lat ? 256 : 320); i0 += G) {
                    const int it = lat ? ((G == 256) ? ((i0 & 7) * 32 + (i0 >> 3)) : i0) : i0 - 256;
                    const int b = lat ? it >> 5 : it >> 3, h = lat ? (it >> 2) & 7 : it & 7, qt = it & 3;
                    const size_t rb = (size_t)b * TPB, r0 = lat ? rb + CTX + qt * 512 : rb;
                    attn_item<96, 64, false>(lds, QM + r0 * 768 + h * 96, 768, KM + rb * 768 + h * 96, 768, VTM + (size_t)(b * 8 + h) * 64 * TPB, lat ? TPB : CTX, lat ? 512 : 256,
                                             Y + r0 * YW + 512 + h * 64, 0.f, 1.f, nullptr);
                }
                __syncthreads();
                {
                    const int cx = lat ? 0 : 1, Kf = cx ? 512 : 2048, ldf = cx ? 512 : 4096;
                    S.c = cx ? (bid + G - 96) % G : bid;
                    S.s0 = pg8::mksub(cx ? DFTC : DFTL, cx ? FTC : FT, cx ? 8 : 128, 2, ldf, ldf); S.s0.mmod = cx ? 1 : 8; S.s0.mode = cx ? 0 : 1; S.s0.zb = (size_t)512 * ldf * 2;
                    EpiF2 E1{Y, cx};
                    pg8::gemm_phase(lds, Kf, ldf, ldf, S, E1);
                }
            } else if (sp == 7) {
                S.s0 = pg8::mksub(Y, W + WE_B, nP, 4, YW, 2048); S.s0.mapM = rs;
                EpiMerge E{MG, GT};
                pg8::gemm_phase(lds, 2048, YW, 2048, S, E);
            } else if (sp == 8) {
                S.s0 = pg8::mksub(MG, W + WE_O, nP, 4, 1024, 1024); S.s0.mapM = rs;
                EpiResid E{H, modl, 5, 1.0f, 0};
                pg8::gemm_phase(lds, 1024, 1024, 1024, S, E);
            }
            __syncthreads();
        }
        if (ph + 1 < p.ph_hi) { if (ph == 0) cg::this_grid().sync(); else xcd_barrier(xbar); }
    }
}

extern "C" void kernel_launch(void* const* d_in, const int* in_sizes, int n_in, void* d_out, int out_size, void* d_ws, size_t ws_size, hipStream_t stream) {
    static int grid = 0;
    if (grid == 0) {
        if (ws_size < WS_NEED) { fprintf(stderr, "kernel_launch: workspace too small: need %zu have %zu\n", (size_t)WS_NEED, ws_size); grid = -1; return; }
        int dev = 0, cus = 0, per_cu = 0;
        hipGetDevice(&dev); hipDeviceGetAttribute(&cus, hipDeviceAttributeMultiprocessorCount, dev);
        if (hipFuncSetAttribute((const void*)fwd_kernel, hipFuncAttributeMaxDynamicSharedMemorySize, LDS_BYTES) != hipSuccess) { fprintf(stderr, "kernel_launch: hipFuncSetAttribute failed\n"); grid = -1; return; }
        if (hipOccupancyMaxActiveBlocksPerMultiprocessor(&per_cu, (const void*)fwd_kernel, NT, LDS_BYTES) != hipSuccess || per_cu < 1) { fprintf(stderr, "kernel_launch: occupancy query says %d\n", per_cu); per_cu = 1; }
        (void)hipGetLastError();
        grid = cus * per_cu;
        fprintf(stderr, "kernel_launch: grid %d (cus %d x %d), ws need %zu have %zu\n", grid, cus, per_cu, (size_t)WS_NEED, ws_size);
    }
    if (grid < 0) return;
    Params p{};
    const float** pp = (const float**)&p;
    for (int i = 0; i < 21; ++i) pp[i] = (const float*)d_in[i];
    p.out = (float*)d_out; p.ws = (unsigned char*)d_ws;
#if ONE_LAUNCH
    if (hipMemsetAsync((char*)d_ws + OFF_BAR, 0, BAR_BYTES, stream) != hipSuccess) { fprintf(stderr, "kernel_launch: memset of the barrier words failed\n"); return; }
    p.ph_lo = 0; p.ph_hi = NPH;
    void* args[] = {&p};
    hipError_t e = hipLaunchCooperativeKernel((const void*)fwd_kernel, dim3(grid), dim3(NT), args, LDS_BYTES, stream);
    if (e != hipSuccess) fprintf(stderr, "cooperative launch failed: %s (grid %d)\n", hipGetErrorString(e), grid);
#else
    for (int ph = 0; ph < NPH; ++ph) {
        p.ph_lo = ph; p.ph_hi = ph + 1;
        hipLaunchKernelGGL(fwd_kernel, dim3(grid), dim3(NT), LDS_BYTES, stream, p);
    }
#endif
}
```
